# Optimizing an MI355X kernel written in HIP

```python
import jax, jax.numpy as jnp
from jax import lax
import numpy as np

D_MODEL = 1024
BATCH = 1
SEQ = 16384
DEPTH = 2

N_META = 16
N_A_LAYERS = DEPTH // 2
N_B_LAYERS = DEPTH - N_A_LAYERS
CONV_W = 3
N_HEADS = 8
QK_NOPE_DIM = 128
QK_ROPE_DIM = 64
V_DIM = 128
Q_RANK = 384
KV_RANK = 256
ROPE_THETA = 10000.0
Q_BLOCK = 128
N_GROUPS = 8
EXPERTS_PER_GROUP = 8
N_EXPERTS = N_GROUPS * EXPERTS_PER_GROUP
TOP_K_IN_GROUP = 2
D_EXPERT = 256
EXPERT_BLOCK = 128
NORM_EPS = 1e-6

kernel_name = 'yoco_shortconv_mla_hier_moe'


def rmsnorm(x, g):
    xf = x.astype(jnp.float32)
    y = xf * lax.rsqrt(jnp.mean(xf * xf, axis=-1, keepdims=True) + NORM_EPS)
    return (y * g.astype(jnp.float32)).astype(x.dtype)


def rope_tables(t):
    inv = ROPE_THETA ** (-jnp.arange(0, QK_ROPE_DIM, 2, dtype=jnp.float32) / QK_ROPE_DIM)
    ang = jnp.arange(t, dtype=jnp.float32)[:, None] * inv[None, :]
    return jnp.cos(ang), jnp.sin(ang)


def apply_rope(x, cos, sin):
    half = x.shape[-1] // 2
    x1, x2 = x[..., :half], x[..., half:]
    cos = cos.astype(x.dtype)
    sin = sin.astype(x.dtype)
    return jnp.concatenate([x1 * cos - x2 * sin, x1 * sin + x2 * cos], axis=-1)


def short_conv_mixer(hn, w_in, conv_w, w_out):
    bcu = hn @ w_in
    b, c, u = jnp.split(bcu, 3, axis=-1)
    z = c * u
    z = lax.conv_general_dilated(z, conv_w.astype(z.dtype), window_strides=(1,),
                                 padding=((CONV_W - 1, 0),),
                                 dimension_numbers=('NWC', 'WIO', 'NWC'),
                                 feature_group_count=z.shape[-1])
    return (b * z) @ w_out


def shared_kv_side(h, kv_g, w_dkv, ckv_g, w_ukv, cos, sin):
    bsz, t, _ = h.shape
    a = rmsnorm(h, kv_g) @ w_dkv
    c_kv = rmsnorm(a[..., :KV_RANK], ckv_g)
    k_rope = apply_rope(a[..., KV_RANK:], cos, sin)
    kv = (c_kv @ w_ukv).reshape(bsz, t, N_HEADS, QK_NOPE_DIM + V_DIM)
    return kv[..., :QK_NOPE_DIM], k_rope, kv[..., QK_NOPE_DIM:]


def causal_block_attention(q_nope, q_rope, k_nope, k_rope, v):
    bsz, t, nh, _ = q_nope.shape
    nqb = -(-t // Q_BLOCK)
    pad = nqb * Q_BLOCK - t
    def blocks(q):
        q = jnp.pad(q, ((0, 0), (0, pad), (0, 0), (0, 0)))
        return q.reshape(bsz, nqb, Q_BLOCK, nh, q.shape[-1]).transpose(1, 0, 2, 3, 4)
    qn, qr = blocks(q_nope), blocks(q_rope)
    kpos = jnp.arange(t)
    scale = (QK_NOPE_DIM + QK_ROPE_DIM) ** -0.5
    def one_block(args):
        qn_b, qr_b, j = args
        qpos = j * Q_BLOCK + jnp.arange(Q_BLOCK)
        s = (jnp.einsum('bqhd,bkhd->bhqk', qn_b, k_nope)
             + jnp.einsum('bqhd,bkd->bhqk', qr_b, k_rope)).astype(jnp.float32) * scale
        s = jnp.where(kpos[None, :] <= qpos[:, None], s, -jnp.inf)
        p = jax.nn.softmax(s, axis=-1).astype(v.dtype)
        return jnp.einsum('bhqk,bkhd->bqhd', p, v)
    o = lax.map(one_block, (qn, qr, jnp.arange(nqb, dtype=jnp.int32)))
    o = o.transpose(1, 0, 2, 3, 4).reshape(bsz, nqb * Q_BLOCK, nh * v.shape[-1])
    return o[:, :t]


def mla_mixer(hn, w_dq, cq_g, w_uq, w_o, k_nope, k_rope, v, cos, sin):
    bsz, t, _ = hn.shape
    cq = rmsnorm(hn @ w_dq, cq_g)
    q = (cq @ w_uq).reshape(bsz, t, N_HEADS, QK_NOPE_DIM + QK_ROPE_DIM)
    q_nope = q[..., :QK_NOPE_DIM]
    q_rope = apply_rope(q[..., QK_NOPE_DIM:], cos[:, None, :], sin[:, None, :])
    o = causal_block_attention(q_nope, q_rope, k_nope, k_rope, v)
    return o @ w_o


def hier_moe(hn, w_grp, w_exp, w_gate, w_up, w_down):
    bsz, t, d = hn.shape
    n = bsz * t
    xf = hn.reshape(n, d)
    g_logits = (xf @ w_grp).astype(jnp.float32)
    p_grp = jax.nn.softmax(g_logits, axis=-1)
    grp = jnp.argmax(g_logits, axis=-1).astype(jnp.int32)
    p_g = jnp.max(p_grp, axis=-1, keepdims=True)
    e_logits = (xf @ w_exp).astype(jnp.float32).reshape(n, N_GROUPS, EXPERTS_PER_GROUP)
    e_in = jnp.einsum('ng,nge->ne', jax.nn.one_hot(grp, N_GROUPS, dtype=jnp.float32), e_logits)
    top_p, top_i = lax.top_k(jax.nn.softmax(e_in, axis=-1), TOP_K_IN_GROUP)
    gate = p_g * top_p / jnp.sum(top_p, axis=-1, keepdims=True)
    expert = grp[:, None] * EXPERTS_PER_GROUP + top_i.astype(jnp.int32)
    a = n * TOP_K_IN_GROUP
    e_a = expert.reshape(a)
    w_a = gate.reshape(a).astype(hn.dtype)
    tok_a = jnp.repeat(jnp.arange(n, dtype=jnp.int32), TOP_K_IN_GROUP)
    counts = jax.ops.segment_sum(jnp.ones((a,), jnp.int32), e_a, num_segments=N_EXPERTS)
    padded = ((counts + EXPERT_BLOCK - 1) // EXPERT_BLOCK) * EXPERT_BLOCK
    pad_end = jnp.cumsum(padded)
    pad_start = pad_end - padded
    start = jnp.cumsum(counts) - counts
    order = jnp.argsort(e_a)
    e_s = e_a[order]
    dest = pad_start[e_s] + jnp.arange(a, dtype=jnp.int32) - start[e_s]
    n_blocks = (a + N_EXPERTS * (EXPERT_BLOCK - 1) + EXPERT_BLOCK - 1) // EXPERT_BLOCK
    p_slots = n_blocks * EXPERT_BLOCK
    slot_tok = jnp.full((p_slots,), n, jnp.int32).at[dest].set(tok_a[order])
    slot_w = jnp.zeros((p_slots,), hn.dtype).at[dest].set(w_a[order])
    blk_expert = jnp.minimum(jnp.searchsorted(pad_end, jnp.arange(n_blocks, dtype=jnp.int32) * EXPERT_BLOCK,
                                              side='right'), N_EXPERTS - 1).astype(jnp.int32)
    x_pad = jnp.concatenate([xf, jnp.zeros((1, d), xf.dtype)], axis=0)
    xs = x_pad[slot_tok].reshape(n_blocks, EXPERT_BLOCK, d)
    def expert_block(args):
        xb, e = args
        hh = jax.nn.silu(xb @ w_gate[e]) * (xb @ w_up[e])
        return hh @ w_down[e]
    ys = lax.map(expert_block, (xs, blk_expert)).reshape(p_slots, d)
    y = jnp.zeros((n + 1, d), ys.dtype).at[slot_tok].add(ys * slot_w[:, None])[:n]
    return y.reshape(bsz, t, d)


def setup_inputs(seed: int = 0) -> dict:
    key = jax.random.key(seed)
    ks = jax.random.split(key, 21)
    def nrm(k, shape, scale):
        return jax.random.normal(k, shape, jnp.float32) * scale
    d = D_MODEL
    return {
        'x': nrm(ks[0], (BATCH, SEQ, d), 1.0),
        'meta_tokens': nrm(ks[1], (N_META, d), 1.0),
        'norm_mix_g': 1.0 + nrm(ks[2], (DEPTH, d), 0.02),
        'norm_ffn_g': 1.0 + nrm(ks[3], (DEPTH, d), 0.02),
        'conv_w_in': nrm(ks[4], (N_A_LAYERS, d, 3 * d), d ** -0.5),
        'conv_w': nrm(ks[5], (N_A_LAYERS, CONV_W, 1, d), CONV_W ** -0.5),
        'conv_w_out': nrm(ks[6], (N_A_LAYERS, d, d), d ** -0.5),
        'kv_norm_g': 1.0 + nrm(ks[7], (d,), 0.02),
        'w_dkv': nrm(ks[8], (d, KV_RANK + QK_ROPE_DIM), d ** -0.5),
        'ckv_norm_g': 1.0 + nrm(ks[9], (KV_RANK,), 0.02),
        'w_ukv': nrm(ks[10], (KV_RANK, N_HEADS * (QK_NOPE_DIM + V_DIM)), KV_RANK ** -0.5),
        'w_dq': nrm(ks[11], (N_B_LAYERS, d, Q_RANK), d ** -0.5),
        'cq_norm_g': 1.0 + nrm(ks[12], (N_B_LAYERS, Q_RANK), 0.02),
        'w_uq': nrm(ks[13], (N_B_LAYERS, Q_RANK, N_HEADS * (QK_NOPE_DIM + QK_ROPE_DIM)), Q_RANK ** -0.5),
        'w_o': nrm(ks[14], (N_B_LAYERS, N_HEADS * V_DIM, d), (N_HEADS * V_DIM) ** -0.5),
        'w_grp': nrm(ks[15], (DEPTH, d, N_GROUPS), d ** -0.5),
        'w_exp': nrm(ks[16], (DEPTH, d, N_EXPERTS), d ** -0.5),
        'w_gate': nrm(ks[17], (DEPTH, N_EXPERTS, d, D_EXPERT), d ** -0.5),
        'w_up': nrm(ks[18], (DEPTH, N_EXPERTS, d, D_EXPERT), d ** -0.5),
        'w_down': nrm(ks[19], (DEPTH, N_EXPERTS, D_EXPERT, d), D_EXPERT ** -0.5),
        'final_norm_g': 1.0 + nrm(ks[20], (d,), 0.02),
    }


def reference(x, meta_tokens, norm_mix_g, norm_ffn_g, conv_w_in, conv_w, conv_w_out,
              kv_norm_g, w_dkv, ckv_norm_g, w_ukv, w_dq, cq_norm_g, w_uq, w_o,
              w_grp, w_exp, w_gate, w_up, w_down, final_norm_g):
    bsz = x.shape[0]
    meta = jnp.broadcast_to(meta_tokens[None].astype(x.dtype), (bsz, N_META, x.shape[-1]))
    h = jnp.concatenate([meta, x], axis=1)
    cos, sin = rope_tables(h.shape[1])
    shared = None
    for i in range(DEPTH):
        if i < N_A_LAYERS:
            h = h + short_conv_mixer(rmsnorm(h, norm_mix_g[i]), conv_w_in[i], conv_w[i], conv_w_out[i])
        else:
            if shared is None:
                shared = shared_kv_side(h, kv_norm_g, w_dkv, ckv_norm_g, w_ukv, cos, sin)
            j = i - N_A_LAYERS
            k_nope, k_rope, v = shared
            h = h + mla_mixer(rmsnorm(h, norm_mix_g[i]), w_dq[j], cq_norm_g[j], w_uq[j], w_o[j],
                              k_nope, k_rope, v, cos, sin)
        h = h + hier_moe(rmsnorm(h, norm_ffn_g[i]), w_grp[i], w_exp[i], w_gate[i], w_up[i], w_down[i])
    return rmsnorm(h, final_norm_g)[:, N_META:]
```

```cpp
#include <hip/hip_runtime.h>
#include <cstdio>
#include <cstdint>

#define GAS __attribute__((address_space(1)))
#define LAS __attribute__((address_space(3)))
typedef unsigned short bf16;
typedef short bf16x8 __attribute__((ext_vector_type(8)));
typedef float f32x4 __attribute__((ext_vector_type(4)));
typedef float f32x16 __attribute__((ext_vector_type(16)));
typedef unsigned u32x4 __attribute__((ext_vector_type(4)));
typedef unsigned u32x2 __attribute__((ext_vector_type(2)));

constexpr int D = 1024, SEQ = 16384, NMETA = 16, T = SEQ + NMETA, TP = 16640;
constexpr int NH = 8, DQK = 192, DV = 128, QRANK = 384, KVRANK = 256;
constexpr int NE = 64, DE = 256;
constexpr int KROWS = 16448, KPAD = 48;
constexpr int CAP = 16400;
constexpr float EPS = 1e-6f;
constexpr float QSCALE = 0.07216878364870322f * 1.4426950408889634f;
constexpr int NWAVES = 8, NTHREADS = 512;

constexpr size_t MiB = 1u << 20;
constexpr size_t WS_CTL = 0, CTL_ZERO_BYTES = 1 * MiB;
constexpr size_t WS_ROPE = 2 * MiB;
constexpr size_t WS_STAT = 7 * MiB;
constexpr size_t WS_TSLOT = 9 * MiB;
constexpr size_t WS_TOK = 10 * MiB;
constexpr size_t WS_WOF = 15 * MiB;
constexpr size_t WS_WIN = 20 * MiB, WS_WOUT = 26 * MiB, WS_WO = 28 * MiB, WS_WKVQ = 30 * MiB, WS_WUKV = 32 * MiB, WS_WUQ = 33 * MiB, WS_WR = 35 * MiB;
constexpr size_t WS_WGU = 36 * MiB;
constexpr size_t WS_WD = 164 * MiB;
constexpr size_t WS_H13 = 228 * MiB, WS_H2 = 261 * MiB, WS_CKV = 294 * MiB, WS_CQ = 303 * MiB;
constexpr size_t WS_ARENA = 316 * MiB;
constexpr size_t AR_K = 0, AR_V = 49 * MiB, AR_Q = 82 * MiB, AR_O = 130 * MiB;
constexpr size_t AR_K8 = 0, AR_VT8 = 26 * MiB, AR_Q8 = 44 * MiB;
constexpr int NKT = 257;
constexpr size_t AR_H0 = 0, AR_B = 33 * MiB, AR_Z = 66 * MiB, AR_A2 = 99 * MiB;
constexpr size_t AR_HH = 0, AR_YS = 24 * MiB;
constexpr size_t WS_H8 = WS_ARENA + 162 * MiB;
constexpr size_t WS_END = WS_H8 + 17 * MiB;
constexpr int ST_RSTD0 = 0, ST_RSTD1 = TP, ST_RSTD2 = 2 * TP, ST_RSTD3 = 3 * TP, ST_SSCKV = 4 * TP, ST_SSCQ = 8 * TP;
constexpr int CW_BAR = 4096, CW_CNT = 8192;

constexpr int LDS_BYTES = 147456;
constexpr int MISC_OFF = 131072;

__device__ const float ROPE_INV[32] = {
    1.000000000e+00f, 7.498942614e-01f, 5.623413324e-01f, 4.216965139e-01f, 3.162277639e-01f, 2.371373773e-01f, 1.778279394e-01f, 1.333521307e-01f,
    1.000000015e-01f, 7.498941571e-02f, 5.623413250e-02f, 4.216965288e-02f, 3.162277490e-02f, 2.371373773e-02f, 1.778279431e-02f, 1.333521493e-02f,
    9.999999776e-03f, 7.498941850e-03f, 5.623413250e-03f, 4.216964822e-03f, 3.162277630e-03f, 2.371373586e-03f, 1.778279431e-03f, 1.333521446e-03f,
    1.000000047e-03f, 7.498942432e-04f, 5.623413017e-04f, 4.216965172e-04f, 3.162277571e-04f, 2.371373703e-04f, 1.778279402e-04f, 1.333521504e-04f};

#define LDS_WAIT() asm volatile("s_waitcnt lgkmcnt(0)" ::: "memory")
#define VM_WAIT() asm volatile("s_waitcnt vmcnt(0)" ::: "memory")
__device__ __forceinline__ unsigned cvtpk(float lo, float hi) { unsigned r; asm("v_cvt_pk_bf16_f32 %0, %1, %2" : "=v"(r) : "v"(lo), "v"(hi)); return r; }
__device__ __forceinline__ u32x4 pack8(f32x4 a, f32x4 b) { u32x4 w; w.x = cvtpk(a[0], a[1]); w.y = cvtpk(a[2], a[3]); w.z = cvtpk(b[0], b[1]); w.w = cvtpk(b[2], b[3]); return w; }
__device__ __forceinline__ float bflo(unsigned w) { return __builtin_bit_cast(float, w << 16); }
__device__ __forceinline__ float bfhi(unsigned w) { return __builtin_bit_cast(float, w & 0xffff0000u); }
__device__ __forceinline__ void unpack8(u32x4 w, float (&f)[8]) { f[0] = bflo(w.x); f[1] = bfhi(w.x); f[2] = bflo(w.y); f[3] = bfhi(w.y); f[4] = bflo(w.z); f[5] = bfhi(w.z); f[6] = bflo(w.w); f[7] = bfhi(w.w); }
__device__ __forceinline__ float wave_sum(float v) {
#pragma unroll
    for (int o = 1; o < 64; o <<= 1) v += __shfl_xor(v, o);
    return v;
}
__device__ __forceinline__ int opq(int v) { asm volatile("" : "+v"(v)); return v; }
__device__ __forceinline__ int crow(int r, int hi) { return (r & 3) + 8 * (r >> 2) + 4 * hi; }

#define XB_TMO      128
#define XB_XCNT(j)  (256  + 64 * (j))
#define XB_XSUB(j)  (1280 + 64 * (j))
#define XB_XGEN(j)  (2304 + 64 * (j))
#define XB_TOP      3328
#define XB_TOPGEN   3392
#define XCD_BAR_WORDS 3456
#define XB_SPIN_CAP (1u << 18)

__device__ __forceinline__ unsigned xb_ld(unsigned* p)              { return __hip_atomic_load(p, __ATOMIC_RELAXED, __HIP_MEMORY_SCOPE_AGENT); }
__device__ __forceinline__ unsigned xb_add(unsigned* p, unsigned v) { return __hip_atomic_fetch_add(p, v, __ATOMIC_RELAXED, __HIP_MEMORY_SCOPE_AGENT); }
__device__ __forceinline__ unsigned xb_xcc_id() { return (unsigned)__builtin_amdgcn_s_getreg((3 << 11) | 20) & 0xFu; }
#define XB_SPIN(cond, bar) do { unsigned _sp = 0; while (cond) { __builtin_amdgcn_s_sleep(1); \
    if ((++_sp & 255u) == 0u) { if (xb_ld(&(bar)[XB_TMO])) break; if (_sp > XB_SPIN_CAP) { atomicAdd(&(bar)[XB_TMO], 1u); break; } } } } while (0)

struct XcdBarrier {
    unsigned* bar; unsigned x;
    volatile LAS unsigned* st;
};
__device__ __forceinline__ XcdBarrier xcd_barrier_post(unsigned* bar, volatile LAS unsigned* st) {
    XcdBarrier b; b.bar = bar; b.x = xb_xcc_id(); b.st = st;
    if (threadIdx.x == 0) (void)xb_add(&bar[XB_XCNT(b.x)], 1u);
    return b;
}
__device__ __forceinline__ void xcd_barrier_complete(unsigned* bar, unsigned x, unsigned& nloc, unsigned& nx) {
    const unsigned G = gridDim.x * gridDim.y * gridDim.z;
    unsigned sum, cnt, mine, sp = 0u;
    for (;;) {
        sum = 0u; cnt = 0u; mine = 0u;
#pragma unroll
        for (unsigned j = 0; j < 16; ++j) { const unsigned c = xb_ld(&bar[XB_XCNT(j)]); sum += c; cnt += (c > 0u) ? 1u : 0u; mine = (j == x) ? c : mine; }
        if (sum == G) break;
        __builtin_amdgcn_s_sleep(1);
        if ((++sp & 255u) == 0u) { if (xb_ld(&bar[XB_TMO])) break; if (sp > XB_SPIN_CAP) { atomicAdd(&bar[XB_TMO], 1u); break; } }
    }
    nloc = mine > 0u ? mine : 1u; nx = cnt > 0u ? cnt : 1u;
}
__device__ __forceinline__ void xcd_barrier(const XcdBarrier& b) {
    asm volatile("s_waitcnt vmcnt(0)" ::: "memory");
    __syncthreads();
    if (threadIdx.x == 0) {
        unsigned* bar = b.bar;
        __builtin_amdgcn_s_waitcnt(0);
        unsigned nloc = b.st[0], nx = b.st[1];
        if (nloc == 0u) { xcd_barrier_complete(bar, b.x, nloc, nx); b.st[0] = nloc; b.st[1] = nx; }
        const unsigned old = xb_add(&bar[XB_XSUB(b.x)], 1u);
        const unsigned gen = old / nloc;
        if (old + 1u == (gen + 1u) * nloc) {
            __builtin_amdgcn_fence(__ATOMIC_RELEASE, "agent");
            asm volatile("s_waitcnt vmcnt(0)" ::: "memory");
            const unsigned og = xb_add(&bar[XB_TOP], 1u);
            const unsigned tg = og / nx;
            if (og + 1u == (tg + 1u) * nx) xb_add(&bar[XB_TOPGEN], 1u);
            else XB_SPIN(xb_ld(&bar[XB_TOPGEN]) == tg, bar);
            __builtin_amdgcn_fence(__ATOMIC_ACQUIRE, "agent");
            xb_add(&bar[XB_XGEN(b.x)], 1u);
            asm volatile("s_waitcnt vmcnt(0)" ::: "memory");
        } else {
            XB_SPIN(xb_ld(&bar[XB_XGEN(b.x)]) == gen, bar);
            __builtin_amdgcn_fence(__ATOMIC_ACQUIRE, "agent");
            asm volatile("s_waitcnt vmcnt(0)" ::: "memory");
        }
    }
    __syncthreads();
}


namespace pg8 {
#define PG8_LAS __attribute__((address_space(3)))
typedef unsigned short bf16_t;
typedef short bf16x8 __attribute__((ext_vector_type(8)));
typedef float f32x4 __attribute__((ext_vector_type(4)));
typedef unsigned u32x4 __attribute__((ext_vector_type(4)));
constexpr int BM = 256, BK = 64, HALF = 128, HTB = HALF * BK * 2  , STAGE_BYTES = 8 * HTB, NXCD = 8, WGM = 8;

__host__ __device__ __forceinline__ int lds_byte(int r, int c) { const int st = (r >> 4) * 2 + (c >> 5), rr = r & 15, cc = c & 31, ob = rr * 64 + cc * 2; return st * 1024 + (ob ^ (((ob >> 9) & 1) << 5)); }
__host__ __device__ __forceinline__ void stage_rc(int b, int& R, int& C) { const int st = b / 1024, sb = b % 1024, swz = sb ^ (((sb >> 9) & 1) << 5); R = (st >> 1) * 16 + swz / 64; C = (st & 1) * 32 + (swz % 64) / 2; }
__host__ __device__ __forceinline__ int perm32(int rho) { const int n = rho >> 4, i = rho & 15; return 8 * (i >> 2) + 4 * n + (i & 3); }

__host__ __device__ __forceinline__ int permkv(int rho) { const int n = rho >> 4, i = rho & 15, q = i >> 2; return 4 * (q & 1) + 16 * (q >> 1) + 8 * n + (i & 3); }
template <class T, class = void> struct has_perm2 { static constexpr bool value = false; };
template <class T> struct has_perm2<T, decltype((void)T::PERM2, void())> { static constexpr bool value = T::PERM2; };
struct Unit { int pm, pn; };
struct Gemm { const bf16_t* A; const bf16_t* Bt; int M, N, K; };

struct StaticOrder {
    int nM, nN, nwg, G, c;
    __host__ __device__ void init(int M, int N, int G_, int c_) { nM = M / BM; nN = N / BM; nwg = nM * nN; G = G_; c = c_; }
    __host__ __device__ bool next(int i, Unit& u) const {
        const long L = (long)i * G + c; if (L >= nwg) return false;
        int wgid = (int)L; { const int q = nwg / NXCD, r = nwg % NXCD, xcd = wgid % NXCD, off = wgid / NXCD; wgid = (xcd < r ? xcd * (q + 1) : r * (q + 1) + (xcd - r) * q) + off; }
        const int nig = WGM * nN, gid = wgid / nig, fm = gid * WGM, gsz = (nM - fm) < WGM ? (nM - fm) : WGM;
        u.pm = fm + ((wgid % nig) % gsz); u.pn = (wgid % nig) / gsz; return true;
    }
    __device__ __forceinline__ void a_ready(const Unit&) const {}
    __device__ __forceinline__ void done(const Unit&) const {}
};
typedef int v4i_ __attribute__((ext_vector_type(4)));
typedef int v8i_ __attribute__((ext_vector_type(8)));
__device__ __forceinline__ void mfma8_tied(f32x4& acc, const v8i_& a, const v8i_& b, unsigned sc) {
    asm volatile("v_mfma_scale_f32_16x16x128_f8f6f4 %0, %1, %2, %0, %3, %3 op_sel_hi:[0,0,0]" : "+v"(acc) : "v"(a), "v"(b), "v"(sc)); }
__device__ __forceinline__ v8i_ cat8(bf16x8 a, bf16x8 b) { return __builtin_shufflevector(__builtin_bit_cast(v4i_, a), __builtin_bit_cast(v4i_, b), 0, 1, 2, 3, 4, 5, 6, 7); }
template <class Epi, class Sched, bool ALIGN_EPI = false, bool SP2 = false, bool F8 = false>
__device__ __forceinline__ void gemm_phase(PG8_LAS unsigned char* lds, const Gemm g, const Sched& S, const Epi& E) {
    int tid_ = threadIdx.x; asm volatile("" : "+v"(tid_));
    const int tid = tid_, wid = __builtin_amdgcn_readfirstlane(tid >> 6), lane = tid & 63, wr = wid >> 2, wc = wid & 3, fr = lane & 15, fq = lane >> 4;
    int K_ = g.K; asm volatile("" : "+s"(K_));
    const int K = K_, nt = K / BK;
    unsigned voffA[2], voffB[2];
#pragma unroll
    for (int i = 0; i < 2; ++i) { int R, C; stage_rc(tid * 16 + i * 8192, R, C); const int Rb = Epi::PERM ? ((R & ~31) + (has_perm2<Epi>::value ? permkv(R & 31) : perm32(R & 31))) : R;
        voffA[i] = (unsigned)(R * K + C) * 2u; voffB[i] = (unsigned)(Rb * K + C) * 2u; }
    const size_t kstep = (size_t)(BK * 2);
    const size_t hstep = (size_t)HALF * K * 2;
    const size_t tstep = 2 * hstep;
    const unsigned ldsw = (unsigned)wid * 1024u;
    const int aoff = lds_byte(wr * 64 + fr, fq * 8), boff = lds_byte(wc * 32 + fr, fq * 8);
#define PG8_SA(b, h) (((b) * 2 + (h)) * HTB)
#define PG8_SB(b, h) ((4 + (b) * 2 + (h)) * HTB)
#define PG8_STAGE(bufoff, gbase, voff) do { _Pragma("unroll") for (int _i = 0; _i < 2; ++_i) \
        __builtin_amdgcn_global_load_lds((const unsigned*)((const char*)(gbase) + (voff)[_i]), (PG8_LAS unsigned*)(lds + (bufoff) + ldsw + _i * 8192), 16, 0, 0); } while (0)
#define PG8_LDA(dst, b, h) do { _Pragma("unroll") for (int m = 0; m < 4; ++m) { \
        if constexpr (F8) dst##8[m] = cat8(*(const PG8_LAS bf16x8*)(lds + PG8_SA(b, h) + aoff + m * 2048), *(const PG8_LAS bf16x8*)(lds + PG8_SA(b, h) + aoff + m * 2048 + 1024)); \
        else { _Pragma("unroll") for (int k = 0; k < 2; ++k) dst[m][k] = *(const PG8_LAS bf16x8*)(lds + PG8_SA(b, h) + aoff + m * 2048 + k * 1024); } } } while (0)
#define PG8_LDB(dst, b, h) do { _Pragma("unroll") for (int n = 0; n < 2; ++n) { \
        if constexpr (F8) dst##8[n] = cat8(*(const PG8_LAS bf16x8*)(lds + PG8_SB(b, h) + boff + n * 2048), *(const PG8_LAS bf16x8*)(lds + PG8_SB(b, h) + boff + n * 2048 + 1024)); \
        else { _Pragma("unroll") for (int k = 0; k < 2; ++k) dst[n][k] = *(const PG8_LAS bf16x8*)(lds + PG8_SB(b, h) + boff + n * 2048 + k * 1024); } } } while (0)
#define PG8_MMA(ai, bj, At, Bt) do { __builtin_amdgcn_s_setprio(1); _Pragma("unroll") for (int m = 0; m < 4; ++m) _Pragma("unroll") for (int n = 0; n < 2; ++n) { \
        if constexpr (F8) mfma8_tied(acc[ai][bj][m][n], Bt##8[n], At##8[m], one8); \
        else { _Pragma("unroll") for (int k = 0; k < 2; ++k) acc[ai][bj][m][n] = __builtin_amdgcn_mfma_f32_16x16x32_bf16(Bt[n][k], At[m][k], acc[ai][bj][m][n], 0, 0, 0); } } \
        __builtin_amdgcn_s_setprio(0); } while (0)
#define PG8_WAIT_V(n) asm volatile("s_waitcnt vmcnt(" #n ")" ::: "memory")
#define PG8_WAIT_L(n) asm volatile("s_waitcnt lgkmcnt(" #n ")" ::: "memory")
#define PG8_BAR __builtin_amdgcn_s_barrier()
#define PG8_SCHED __builtin_amdgcn_sched_barrier(0)
    Unit cur, nxt; int ui = 0;
    if (!S.next(0, cur)) return;
    f32x4 acc[2][2][4][2];
#pragma unroll
    for (int a = 0; a < 2; ++a)
#pragma unroll
        for (int b = 0; b < 2; ++b)
#pragma unroll
            for (int m = 0; m < 4; ++m)
#pragma unroll
                for (int n = 0; n < 2; ++n) acc[a][b][m][n] = (f32x4){0.f, 0.f, 0.f, 0.f};
    bf16x8 At[4][2], B0[2][2], B1[2][2]; v8i_ At8[4], B08[2], B18[2];
    unsigned one8 = 0x7f7f7f7fu; asm volatile("" : "+v"(one8));
    const char* cA = (const char*)g.A + (size_t)cur.pm * tstep; const char* cB = (const char*)g.Bt + (size_t)cur.pn * tstep;
    S.a_ready(cur);
    if constexpr (SP2) {
        PG8_STAGE(PG8_SB(0, 0), cB, voffB); PG8_STAGE(PG8_SB(0, 1), cB + hstep, voffB); PG8_STAGE(PG8_SA(0, 0), cA, voffA); PG8_STAGE(PG8_SA(0, 1), cA + hstep, voffA);
        if (wr == 1) PG8_BAR;
        PG8_WAIT_V(2); PG8_BAR;
        PG8_STAGE(PG8_SB(1, 0), cB + kstep, voffB); PG8_STAGE(PG8_SA(1, 0), cA + kstep, voffA); PG8_STAGE(PG8_SB(1, 1), cB + hstep + kstep, voffB);
        PG8_WAIT_V(6); PG8_BAR;
    } else {
        PG8_STAGE(PG8_SB(0, 0), cB, voffB); PG8_STAGE(PG8_SA(0, 0), cA, voffA); PG8_STAGE(PG8_SB(0, 1), cB + hstep, voffB); PG8_STAGE(PG8_SA(0, 1), cA + hstep, voffA);
        if (wr == 1) PG8_BAR;
        PG8_WAIT_V(4); PG8_BAR;
        PG8_STAGE(PG8_SB(1, 0), cB + kstep, voffB); PG8_STAGE(PG8_SA(1, 0), cA + kstep, voffA); PG8_STAGE(PG8_SB(1, 1), cB + hstep + kstep, voffB);
        PG8_WAIT_V(6); PG8_BAR;
    }
    for (;;) {
        const bool has_next = S.next(ui + 1, nxt);
        const char* nA = has_next ? (const char*)g.A + (size_t)nxt.pm * tstep : cA; const char* nB = has_next ? (const char*)g.Bt + (size_t)nxt.pn * tstep : cB;
#pragma unroll 1
        for (int t = 0; t < nt; t += 2) {
            const bool last = (t == nt - 2);
            const char* a1 = cA + (size_t)(t + 1) * kstep;
            const char* a2 = last ? nA : cA + (size_t)(t + 2) * kstep; const char* b2 = last ? nB : cB + (size_t)(t + 2) * kstep;
            const char* a3 = a2 + kstep; const char* b3 = b2 + kstep;
            if (last && has_next) S.a_ready(nxt);
            if constexpr (SP2) {
            PG8_LDB(B0, 0, 0); PG8_LDB(B1, 0, 1); PG8_SCHED; PG8_LDA(At, 0, 0); PG8_STAGE(PG8_SA(1, 1), a1 + hstep, voffA);
            PG8_WAIT_V(8); PG8_WAIT_L(0); PG8_BAR; PG8_MMA(0, 0, At, B0); PG8_MMA(0, 1, At, B1); PG8_BAR; PG8_SCHED;
            PG8_LDA(At, 0, 1); PG8_STAGE(PG8_SB(0, 0), b2, voffB); PG8_STAGE(PG8_SB(0, 1), b2 + hstep, voffB); PG8_STAGE(PG8_SA(0, 0), a2, voffA);
            PG8_WAIT_V(8); PG8_WAIT_L(0); PG8_BAR; PG8_MMA(1, 0, At, B0); PG8_MMA(1, 1, At, B1); PG8_BAR; PG8_SCHED;
            PG8_LDB(B0, 1, 0); PG8_LDB(B1, 1, 1); PG8_SCHED; PG8_LDA(At, 1, 0); PG8_STAGE(PG8_SA(0, 1), a2 + hstep, voffA);
            PG8_WAIT_V(8); PG8_WAIT_L(0); PG8_BAR; PG8_MMA(0, 0, At, B0); PG8_MMA(0, 1, At, B1); PG8_BAR; PG8_SCHED;
            PG8_LDA(At, 1, 1); PG8_STAGE(PG8_SB(1, 0), b3, voffB); PG8_STAGE(PG8_SB(1, 1), b3 + hstep, voffB); PG8_STAGE(PG8_SA(1, 0), a3, voffA);
            PG8_WAIT_V(8); PG8_WAIT_L(0); PG8_BAR; PG8_MMA(1, 0, At, B0); PG8_MMA(1, 1, At, B1); PG8_BAR; PG8_SCHED;
            } else {
            PG8_LDB(B0, 0, 0); PG8_SCHED; PG8_LDA(At, 0, 0); PG8_STAGE(PG8_SA(1, 1), a1 + hstep, voffA);
            PG8_WAIT_L(8); PG8_BAR; PG8_WAIT_L(0); PG8_MMA(0, 0, At, B0); PG8_BAR; PG8_SCHED;
            PG8_LDB(B1, 0, 1); PG8_STAGE(PG8_SB(0, 0), b2, voffB);
            PG8_BAR; PG8_WAIT_L(0); PG8_MMA(0, 1, At, B1); PG8_BAR;
            PG8_LDA(At, 0, 1); PG8_STAGE(PG8_SA(0, 0), a2, voffA);
            PG8_BAR; PG8_WAIT_L(0); PG8_MMA(1, 0, At, B0); PG8_BAR; PG8_SCHED;
            PG8_STAGE(PG8_SB(0, 1), b2 + hstep, voffB);
            PG8_WAIT_V(6); PG8_BAR; PG8_MMA(1, 1, At, B1); PG8_BAR;
            PG8_LDB(B0, 1, 0); PG8_SCHED; PG8_LDA(At, 1, 0); PG8_STAGE(PG8_SA(0, 1), a2 + hstep, voffA);
            PG8_WAIT_L(8); PG8_BAR; PG8_WAIT_L(0); PG8_MMA(0, 0, At, B0); PG8_BAR; PG8_SCHED;
            PG8_LDB(B1, 1, 1); PG8_STAGE(PG8_SB(1, 0), b3, voffB);
            PG8_BAR; PG8_WAIT_L(0); PG8_MMA(0, 1, At, B1); PG8_BAR;
            PG8_LDA(At, 1, 1); PG8_STAGE(PG8_SA(1, 0), a3, voffA);
            PG8_BAR; PG8_WAIT_L(0); PG8_MMA(1, 0, At, B0); PG8_BAR; PG8_SCHED;
            PG8_STAGE(PG8_SB(1, 1), b3 + hstep, voffB);
            PG8_WAIT_V(6); PG8_BAR; PG8_MMA(1, 1, At, B1); PG8_BAR;
            }
        }
        if constexpr (ALIGN_EPI) { if (wr == 0) PG8_BAR; }
        if constexpr (F8) asm volatile("s_nop 15\n\ts_nop 7" ::: "memory");
        if constexpr (!Epi::AFTER_DRAIN) { E(acc, cur, wr, wc, fr, fq); S.done(cur); }
        if (!has_next) break;
#pragma unroll
        for (int a = 0; a < 2; ++a)
#pragma unroll
            for (int b = 0; b < 2; ++b)
#pragma unroll
                for (int m = 0; m < 4; ++m)
#pragma unroll
                    for (int n = 0; n < 2; ++n) acc[a][b][m][n] = (f32x4){0.f, 0.f, 0.f, 0.f};
        cur = nxt; cA = nA; cB = nB; ++ui;
        if constexpr (ALIGN_EPI) { if (wr == 1) PG8_BAR; }
    }
    PG8_WAIT_V(0);
    if constexpr (!ALIGN_EPI) { if (wr == 0) PG8_BAR; }
    PG8_BAR;
    if constexpr (Epi::AFTER_DRAIN) { E.fused(acc, cur, wr, wc, fr, fq, lds, wid, lane); S.done(cur); }
#undef PG8_SA
#undef PG8_SB
#undef PG8_STAGE
#undef PG8_LDA
#undef PG8_LDB
#undef PG8_MMA
#undef PG8_WAIT_V
#undef PG8_WAIT_L
#undef PG8_BAR
#undef PG8_SCHED
}
}

namespace pg8 {
struct MUnit { int pm, pn, slot; const bf16_t* bt; };
template <class Epi, class Sched, bool ALIGN_EPI, bool GATHER, bool F8 = false>
__device__ __forceinline__ void gemm_phase_moe(PG8_LAS unsigned char* lds, const bf16_t* Abase, int Kin, const Sched& S, const Epi& E, const PG8_LAS unsigned* rowoff_tab, int tab_stride) {
    int tid_ = threadIdx.x; asm volatile("" : "+v"(tid_));
    const int tid = tid_, wid = __builtin_amdgcn_readfirstlane(tid >> 6), lane = tid & 63, wr = wid >> 2, wc = wid & 3, fr = lane & 15, fq = lane >> 4;
    int K_ = Kin; asm volatile("" : "+s"(K_));
    const int K = K_, nt = K / BK;
    unsigned voffA[2], voffB[2]; int RA[2]; unsigned CA[2];
#pragma unroll
    for (int i = 0; i < 2; ++i) { int R, C; stage_rc(tid * 16 + i * 8192, R, C); const int Rb = Epi::PERM ? ((R & ~31) + perm32(R & 31)) : R;
        voffA[i] = (unsigned)(R * K + C) * 2u; voffB[i] = (unsigned)(Rb * K + C) * 2u; RA[i] = R; CA[i] = (unsigned)C * 2u; }
    const size_t kstep = (size_t)(BK * 2);
    const size_t hstep = (size_t)HALF * K * 2;
    const size_t tstep = 2 * hstep;
    const unsigned ldsw = (unsigned)wid * 1024u;
    const int aoff = lds_byte(wr * 64 + fr, fq * 8), boff = lds_byte(wc * 32 + fr, fq * 8);
#define PG8_SA(b, h) (((b) * 2 + (h)) * HTB)
#define PG8_SB(b, h) ((4 + (b) * 2 + (h)) * HTB)
#define PG8_STAGE(bufoff, gbase, voff) do { _Pragma("unroll") for (int _i = 0; _i < 2; ++_i) \
        __builtin_amdgcn_global_load_lds((const unsigned*)((const char*)(gbase) + (voff)[_i]), (PG8_LAS unsigned*)(lds + (bufoff) + ldsw + _i * 8192), 16, 0, 0); } while (0)
#define PG8_LDA(dst, b, h) do { _Pragma("unroll") for (int m = 0; m < 4; ++m) { \
        if constexpr (F8) dst##8[m] = cat8(*(const PG8_LAS bf16x8*)(lds + PG8_SA(b, h) + aoff + m * 2048), *(const PG8_LAS bf16x8*)(lds + PG8_SA(b, h) + aoff + m * 2048 + 1024)); \
        else { _Pragma("unroll") for (int k = 0; k < 2; ++k) dst[m][k] = *(const PG8_LAS bf16x8*)(lds + PG8_SA(b, h) + aoff + m * 2048 + k * 1024); } } } while (0)
#define PG8_LDB(dst, b, h) do { _Pragma("unroll") for (int n = 0; n < 2; ++n) { \
        if constexpr (F8) dst##8[n] = cat8(*(const PG8_LAS bf16x8*)(lds + PG8_SB(b, h) + boff + n * 2048), *(const PG8_LAS bf16x8*)(lds + PG8_SB(b, h) + boff + n * 2048 + 1024)); \
        else { _Pragma("unroll") for (int k = 0; k < 2; ++k) dst[n][k] = *(const PG8_LAS bf16x8*)(lds + PG8_SB(b, h) + boff + n * 2048 + k * 1024); } } } while (0)
#define PG8_MMA(ai, bj, At, Bt) do { __builtin_amdgcn_s_setprio(1); _Pragma("unroll") for (int m = 0; m < 4; ++m) _Pragma("unroll") for (int n = 0; n < 2; ++n) { \
        if constexpr (F8) mfma8_tied(acc[ai][bj][m][n], Bt##8[n], At##8[m], one8); \
        else { _Pragma("unroll") for (int k = 0; k < 2; ++k) acc[ai][bj][m][n] = __builtin_amdgcn_mfma_f32_16x16x32_bf16(Bt[n][k], At[m][k], acc[ai][bj][m][n], 0, 0, 0); } } \
        __builtin_amdgcn_s_setprio(0); } while (0)
#define PG8_WAIT_V(n) asm volatile("s_waitcnt vmcnt(" #n ")" ::: "memory")
#define PG8_WAIT_L(n) asm volatile("s_waitcnt lgkmcnt(" #n ")" ::: "memory")
#define PG8_BAR __builtin_amdgcn_s_barrier()
#define PG8_SCHED __builtin_amdgcn_sched_barrier(0)
#define PG8_UA(u) (GATHER ? (const char*)Abase : (const char*)Abase + (size_t)(u).pm * tstep)
#define PG8_LOADOFF(u, v0, v1) do { _Pragma("unroll") for (int _i = 0; _i < 2; ++_i) { \
        if (GATHER) { v0[_i] = rowoff_tab[(u).slot * tab_stride + RA[_i]] + CA[_i]; v1[_i] = rowoff_tab[(u).slot * tab_stride + HALF + RA[_i]] + CA[_i]; } \
        else { v0[_i] = voffA[_i]; v1[_i] = voffA[_i] + (unsigned)hstep; } } } while (0)
    MUnit cur, nxt; int ui = 0;
    if (!S.next(0, cur)) return;
    f32x4 acc[2][2][4][2];
#pragma unroll
    for (int a = 0; a < 2; ++a)
#pragma unroll
        for (int b = 0; b < 2; ++b)
#pragma unroll
            for (int m = 0; m < 4; ++m)
#pragma unroll
                for (int n = 0; n < 2; ++n) acc[a][b][m][n] = (f32x4){0.f, 0.f, 0.f, 0.f};
    bf16x8 At[4][2], B0[2][2], B1[2][2]; v8i_ At8[4], B08[2], B18[2];
    unsigned one8 = 0x7f7f7f7fu; asm volatile("" : "+v"(one8));
    const char* cA = PG8_UA(cur); const char* cB = (const char*)cur.bt;
    unsigned cv0[2], cv1[2], nv0[2], nv1[2];
    PG8_LOADOFF(cur, cv0, cv1);
    PG8_STAGE(PG8_SB(0, 0), cB, voffB); PG8_STAGE(PG8_SB(0, 1), cB + hstep, voffB); PG8_STAGE(PG8_SA(0, 0), cA, cv0); PG8_STAGE(PG8_SA(0, 1), cA, cv1);
    if (wr == 1) PG8_BAR;
    PG8_WAIT_V(2); PG8_BAR;
    PG8_STAGE(PG8_SB(1, 0), cB + kstep, voffB); PG8_STAGE(PG8_SA(1, 0), cA + kstep, cv0); PG8_STAGE(PG8_SB(1, 1), cB + hstep + kstep, voffB);
    PG8_WAIT_V(6); PG8_BAR;
    for (;;) {
        const bool has_next = S.next(ui + 1, nxt);
        const char* nA = has_next ? PG8_UA(nxt) : cA; const char* nB = has_next ? (const char*)nxt.bt : cB;
        if (has_next) { PG8_LOADOFF(nxt, nv0, nv1); } else { _Pragma("unroll") for (int _i = 0; _i < 2; ++_i) { nv0[_i] = cv0[_i]; nv1[_i] = cv1[_i]; } }
#pragma unroll 1
        for (int t = 0; t < nt; t += 2) {
            const bool last = (t == nt - 2);
            const char* a1 = cA + (size_t)(t + 1) * kstep;
            const char* a2 = last ? nA : cA + (size_t)(t + 2) * kstep; const char* b2 = last ? nB : cB + (size_t)(t + 2) * kstep;
            const char* a3 = a2 + kstep; const char* b3 = b2 + kstep;
            unsigned x0[2], x1[2];
#pragma unroll
            for (int _i = 0; _i < 2; ++_i) { x0[_i] = last ? nv0[_i] : cv0[_i]; x1[_i] = last ? nv1[_i] : cv1[_i]; }
            PG8_LDB(B0, 0, 0); PG8_LDB(B1, 0, 1); PG8_SCHED; PG8_LDA(At, 0, 0); PG8_STAGE(PG8_SA(1, 1), a1, cv1);
            PG8_WAIT_V(8); PG8_WAIT_L(0); PG8_BAR; PG8_MMA(0, 0, At, B0); PG8_MMA(0, 1, At, B1); PG8_BAR; PG8_SCHED;
            PG8_LDA(At, 0, 1); PG8_STAGE(PG8_SB(0, 0), b2, voffB); PG8_STAGE(PG8_SB(0, 1), b2 + hstep, voffB); PG8_STAGE(PG8_SA(0, 0), a2, x0);
            PG8_WAIT_V(8); PG8_WAIT_L(0); PG8_BAR; PG8_MMA(1, 0, At, B0); PG8_MMA(1, 1, At, B1); PG8_BAR; PG8_SCHED;
            PG8_LDB(B0, 1, 0); PG8_LDB(B1, 1, 1); PG8_SCHED; PG8_LDA(At, 1, 0); PG8_STAGE(PG8_SA(0, 1), a2, x1);
            PG8_WAIT_V(8); PG8_WAIT_L(0); PG8_BAR; PG8_MMA(0, 0, At, B0); PG8_MMA(0, 1, At, B1); PG8_BAR; PG8_SCHED;
            PG8_LDA(At, 1, 1); PG8_STAGE(PG8_SB(1, 0), b3, voffB); PG8_STAGE(PG8_SB(1, 1), b3 + hstep, voffB); PG8_STAGE(PG8_SA(1, 0), a3, x0);
            PG8_WAIT_V(8); PG8_WAIT_L(0); PG8_BAR; PG8_MMA(1, 0, At, B0); PG8_MMA(1, 1, At, B1); PG8_BAR; PG8_SCHED;
        }
        if constexpr (ALIGN_EPI) { if (wr == 0) PG8_BAR; }
        if constexpr (F8) asm volatile("s_nop 15\n\ts_nop 7" ::: "memory");
        E(acc, cur, wr, wc, fr, fq);
        if (!has_next) break;
#pragma unroll
        for (int a = 0; a < 2; ++a)
#pragma unroll
            for (int b = 0; b < 2; ++b)
#pragma unroll
                for (int m = 0; m < 4; ++m)
#pragma unroll
                    for (int n = 0; n < 2; ++n) acc[a][b][m][n] = (f32x4){0.f, 0.f, 0.f, 0.f};
        cur = nxt; cA = nA; cB = nB; ++ui;
#pragma unroll
        for (int _i = 0; _i < 2; ++_i) { cv0[_i] = nv0[_i]; cv1[_i] = nv1[_i]; }
        if constexpr (ALIGN_EPI) { if (wr == 1) PG8_BAR; }
    }
    PG8_WAIT_V(0);
    if constexpr (!ALIGN_EPI) { if (wr == 0) PG8_BAR; }
    PG8_BAR;
#undef PG8_SA
#undef PG8_SB
#undef PG8_STAGE
#undef PG8_LDA
#undef PG8_LDB
#undef PG8_MMA
#undef PG8_WAIT_V
#undef PG8_WAIT_L
#undef PG8_BAR
#undef PG8_SCHED
#undef PG8_UA
#undef PG8_LOADOFF
}
}

template <class Fn> struct EpiRows {
    static constexpr bool PERM = true, AFTER_DRAIN = false, PERM2 = pg8::has_perm2<Fn>::value;
    Fn f; int prow0;
    __device__ __forceinline__ void operator()(const pg8::f32x4 (&acc)[2][2][4][2], const pg8::Unit& u, int wr, int wc, int fr, int fq) const {
#pragma unroll
        for (int ai = 0; ai < 2; ++ai)
#pragma unroll
            for (int m = 0; m < 4; ++m) f.row(prow0 + u.pm * 256 + ai * 128 + wr * 64 + m * 16 + fr, u.pn, wc, fq, acc[ai][0][m][0], acc[ai][0][m][1], acc[ai][1][m][0], acc[ai][1][m][1], true);
    }
};

struct Params { const float* in[21]; float* out; unsigned char* ws; int pad0, pad1; };
enum { I_X = 0, I_META, I_GMIX, I_GFFN, I_WIN, I_CONVW, I_WOUT, I_KVG, I_WDKV, I_CKVG, I_WUKV, I_WDQ, I_CQG, I_WUQ, I_WO, I_WGRP, I_WEXP, I_WGATE, I_WUP, I_WDOWN, I_FG };

struct Frame {
    LAS unsigned char* lds;
    int tid, wave, gw, ngw;
    unsigned char* ws; const Params* P;
};
#define FIN(i) (F.P->in[i])
#define WSP(TYPE, off) ((TYPE*)(F.ws + (off)))
#define ARP(TYPE, off) ((TYPE*)(F.ws + WS_ARENA + (off)))
#define F_CTL   WSP(unsigned, WS_CTL)
#define F_STAT  WSP(float, WS_STAT)
#define F_ROPE  WSP(float, WS_ROPE)
#define F_TSLOT WSP(unsigned, WS_TSLOT)
#define F_TOK   WSP(int, WS_TOK)
#define F_WOF   WSP(float, WS_WOF)
#define F_WIN   WSP(bf16, WS_WIN)
#define F_WOUT  WSP(bf16, WS_WOUT)
#define F_WO    WSP(bf16, WS_WO)
#define F_WKVQ  WSP(bf16, WS_WKVQ)
#define F_WUKV  WSP(bf16, WS_WUKV)
#define F_WUQ   WSP(bf16, WS_WUQ)
#define F_WR    WSP(bf16, WS_WR)
#define F_WGU   WSP(bf16, WS_WGU)
#define F_WD    WSP(bf16, WS_WD)
#define F_H13   WSP(bf16, WS_H13)
#define F_H2    WSP(bf16, WS_H2)
#define F_CKV   WSP(bf16, WS_CKV)
#define F_CQ    WSP(bf16, WS_CQ)
#define F_H8    WSP(unsigned char, WS_H8)
#define F_KB    ARP(bf16, AR_K)
#define F_VB    ARP(bf16, AR_V)
#define F_QB    ARP(bf16, AR_Q)
#define F_OB    ARP(bf16, AR_O)
#define F_O8    ARP(unsigned char, AR_O)
#define F_K8    ARP(unsigned char, AR_K8)
#define F_VT8   ARP(unsigned char, AR_VT8)
#define F_Q8    ARP(unsigned char, AR_Q8)
#define F_WK    WSP(bf16, WS_WUKV)
#define F_WV    WSP(bf16, WS_WUKV + 512 * 1024)
#define F_H0B   ARP(bf16, AR_H0)
#define F_BB    ARP(bf16, AR_B)
#define F_ZB    ARP(bf16, AR_Z)
#define F_A2    ARP(bf16, AR_A2)
#define F_HH    ARP(bf16, AR_HH)
#define F_YS    ARP(bf16, AR_YS)

template <int MT>
__device__ __forceinline__ void wave_mma(const bf16* const (&arow)[MT], const bf16* bt, int K, int lane, f32x4 (&acc)[MT][2][2], int ldb = 0) {
    const int i = lane & 15, kq = lane >> 4;
    if (ldb == 0) ldb = K;
    const bf16* brow[2][2];
#pragma unroll
    for (int h = 0; h < 2; ++h)
#pragma unroll
        for (int n = 0; n < 2; ++n) brow[h][n] = bt + (size_t)(128 * h + 8 * (i >> 2) + 4 * n + (i & 3)) * ldb + kq * 8;
#pragma unroll
    for (int m = 0; m < MT; ++m)
#pragma unroll
        for (int h = 0; h < 2; ++h)
#pragma unroll
            for (int n = 0; n < 2; ++n) acc[m][h][n] = (f32x4){0.f, 0.f, 0.f, 0.f};
#pragma unroll 4
    for (int k0 = 0; k0 < K; k0 += 32) {
        bf16x8 a[MT], b[2][2];
#pragma unroll
        for (int m = 0; m < MT; ++m) a[m] = *(const bf16x8*)(arow[m] + k0 + kq * 8);
#pragma unroll
        for (int h = 0; h < 2; ++h)
#pragma unroll
            for (int n = 0; n < 2; ++n) b[h][n] = *(const bf16x8*)(brow[h][n] + k0);
#pragma unroll
        for (int m = 0; m < MT; ++m)
#pragma unroll
            for (int h = 0; h < 2; ++h)
#pragma unroll
                for (int n = 0; n < 2; ++n) acc[m][h][n] = __builtin_amdgcn_mfma_f32_16x16x32_bf16(b[h][n], a[m], acc[m][h][n], 0, 0, 0);
    }
}
template <int MT, class Epi>
__device__ __forceinline__ void sgemm(const Frame& F, const bf16* A, int lda, int M, int prow0, const bf16* Bt, int N, int K, const Epi& E) {
    const int lane_ = (opq(F.tid) & 63), fr = lane_ & 15, fq = lane_ >> 4;
    const int nrb = (M + 16 * MT - 1) / (16 * MT), ntn = N / 256, nunits = nrb * ntn * 4;
    for (int u = F.gw; u < nunits; u += F.ngw) {
        const int g = u & 3, pn = (u >> 2) % ntn, rb = (u >> 2) / ntn;
        const bf16* arow[MT]; int rr[MT];
#pragma unroll
        for (int m = 0; m < MT; ++m) { rr[m] = rb * 16 * MT + m * 16 + fr; const int rc = rr[m] < M ? rr[m] : M - 1; arow[m] = A + (size_t)rc * lda; }
        f32x4 acc[MT][2][2];
        wave_mma<MT>(arow, Bt + (size_t)(pn * 256 + g * 32) * K, K, lane_, acc);
#pragma unroll
        for (int m = 0; m < MT; ++m) E.row(prow0 + rr[m], pn, g, fq, acc[m][0][0], acc[m][0][1], acc[m][1][0], acc[m][1][1], rr[m] < M);
    }
}

__device__ __forceinline__ void st8(bf16* p, f32x4 a, f32x4 b) { *(u32x4*)p = pack8(a, b); }
__device__ __forceinline__ u32x2 pk8_fp8(f32x4 a, f32x4 b);

struct EpiIn {
    bf16* Bb; bf16* Zb; const float* rstd0;
    __device__ __forceinline__ void row(int p, int pn, int wc, int fq, f32x4 a0, f32x4 a1, f32x4 b0, f32x4 b1, bool valid) const {
        if (!valid) return;
        const float s = rstd0[p]; const int c = 32 * wc + 8 * fq;
        if (pn < 4) { st8(Bb + (size_t)p * D + 256 * pn + c, a0 * s, a1 * s); st8(Bb + (size_t)p * D + 256 * pn + 128 + c, b0 * s, b1 * s); }
        else { const float s2 = s * s; st8(Zb + (size_t)p * D + 128 * (pn - 4) + c, a0 * b0 * s2, a1 * b1 * s2); }
    }
};
struct EpiOut {
    bf16* __restrict__ H; const bf16* __restrict__ H0; unsigned char* __restrict__ H8;
    __device__ __forceinline__ void row(int p, int pn, int wc, int fq, f32x4 a0, f32x4 a1, f32x4 b0, f32x4 b1, bool valid) const {
        if (!valid) return;
        const int c = 256 * pn + 32 * wc + 8 * fq;
        const u32x4 r = *(const u32x4*)(H0 + (size_t)p * D + c), q = *(const u32x4*)(H0 + (size_t)p * D + c + 128);
        const f32x4 o0 = a0 + (f32x4){bflo(r.x), bfhi(r.x), bflo(r.y), bfhi(r.y)}, o1 = a1 + (f32x4){bflo(r.z), bfhi(r.z), bflo(r.w), bfhi(r.w)};
        const f32x4 o2 = b0 + (f32x4){bflo(q.x), bfhi(q.x), bflo(q.y), bfhi(q.y)}, o3 = b1 + (f32x4){bflo(q.z), bfhi(q.z), bflo(q.w), bfhi(q.w)};
        st8(H + (size_t)p * D + c, o0, o1); st8(H + (size_t)p * D + c + 128, o2, o3);
        *(u32x2*)(H8 + (size_t)p * D + c) = pk8_fp8(o0, o1); *(u32x2*)(H8 + (size_t)p * D + c + 128) = pk8_fp8(o2, o3);
    }
};
struct EpiRes {
    bf16* __restrict__ H; const bf16* __restrict__ Hin; unsigned char* __restrict__ H8; float sc; int pad_;
    __device__ __forceinline__ void row(int p, int pn, int wc, int fq, f32x4 a0, f32x4 a1, f32x4 b0, f32x4 b1, bool valid) const {
        if (!valid) return;
        const int c = 256 * pn + 32 * wc + 8 * fq;
        const u32x4 r = *(const u32x4*)(Hin + (size_t)p * D + c), q = *(const u32x4*)(Hin + (size_t)p * D + c + 128);
        const f32x4 o0 = a0 * sc + (f32x4){bflo(r.x), bfhi(r.x), bflo(r.y), bfhi(r.y)}, o1 = a1 * sc + (f32x4){bflo(r.z), bfhi(r.z), bflo(r.w), bfhi(r.w)};
        const f32x4 o2 = b0 * sc + (f32x4){bflo(q.x), bfhi(q.x), bflo(q.y), bfhi(q.y)}, o3 = b1 * sc + (f32x4){bflo(q.z), bfhi(q.z), bflo(q.w), bfhi(q.w)};
        st8(H + (size_t)p * D + c, o0, o1); st8(H + (size_t)p * D + c + 128, o2, o3);
        *(u32x2*)(H8 + (size_t)p * D + c) = pk8_fp8(o0, o1); *(u32x2*)(H8 + (size_t)p * D + c + 128) = pk8_fp8(o2, o3);
    }
};
__device__ __forceinline__ float sumsq8(f32x4 a, f32x4 b) { return (a[0] * a[0] + a[1] * a[1]) + (a[2] * a[2] + a[3] * a[3]) + (b[0] * b[0] + b[1] * b[1]) + (b[2] * b[2] + b[3] * b[3]); }
__device__ __forceinline__ void rope8(const float* cs, f32x4 a0, f32x4 a1, f32x4 b0, f32x4 b1, f32x4& o1a, f32x4& o1b, f32x4& o2a, f32x4& o2b) {
#pragma unroll
    for (int j = 0; j < 4; ++j) { const float c0 = cs[2 * j], s0 = cs[2 * j + 1], c1 = cs[2 * (j + 4)], s1 = cs[2 * (j + 4) + 1];
        o1a[j] = a0[j] * c0 - b0[j] * s0; o2a[j] = a0[j] * s0 + b0[j] * c0; o1b[j] = a1[j] * c1 - b1[j] * s1; o2b[j] = a1[j] * s1 + b1[j] * c1; }
}
__device__ __forceinline__ void krope_store(bf16* Kb, int p, int i0, f32x4 o1a, f32x4 o1b, f32x4 o2a, f32x4 o2b) {
    const u32x4 w1 = pack8(o1a, o1b), w2 = pack8(o2a, o2b);
#pragma unroll
    for (int h = 0; h < NH; ++h) { bf16* kr = Kb + ((size_t)h * KROWS + p + KPAD) * DQK + 128; *(u32x4*)(kr + i0) = w1; *(u32x4*)(kr + 32 + i0) = w2; }
}
__device__ __forceinline__ size_t k8_off(int h, int row, int col) { return (size_t)h * KROWS * DQK + (size_t)(row >> 6) * (64 * DQK) + (size_t)((col >> 4) * 1024 + (row & 63) * 16 + (col & 15)); }
__device__ __forceinline__ size_t vt8_off(int h, int T, int d, int slot) { return ((size_t)h * NKT + T) * 8192 + (size_t)((slot >> 4) * 2048 + d * 16 + (slot & 15)); }
__device__ __forceinline__ void krope_store8(unsigned char* K8, int p, int i0, f32x4 o1a, f32x4 o1b, f32x4 o2a, f32x4 o2b);
struct EpiKvqFused {
    static constexpr bool PERM = true, AFTER_DRAIN = true;
    bf16* CKV; bf16* CQ; unsigned char* K8; const float* rstd2; float* sscq; const float* rope;
    __device__ __forceinline__ void fused(const f32x4 (&acc)[2][2][4][2], const pg8::Unit& u, int wr, int wc, int fr, int fq, LAS unsigned char* lds, int wid, int lane) const {
        LAS float* red = (LAS float*)lds;
        const int pn = u.pn;
#pragma unroll
        for (int ai = 0; ai < 2; ++ai)
#pragma unroll
            for (int m = 0; m < 4; ++m) { const int rl = ai * 128 + wr * 64 + m * 16 + fr;
                float ss = sumsq8(acc[ai][0][m][0], acc[ai][0][m][1]);
                if (pn < 2 || wc == 0) ss += sumsq8(acc[ai][1][m][0], acc[ai][1][m][1]);
                if (pn == 2 && wc == 3) ss = 0.f;
                ss += __shfl_xor(ss, 16); ss += __shfl_xor(ss, 32);
                if (fq == 0) red[rl * 4 + wc] = ss; }
        __syncthreads();
        const int c = 32 * wc + 8 * fq;
#pragma unroll
        for (int ai = 0; ai < 2; ++ai)
#pragma unroll
            for (int m = 0; m < 4; ++m) { const int rl = ai * 128 + wr * 64 + m * 16 + fr, p = NMETA + u.pm * 256 + rl;
                const float s = rstd2[p]; const f32x4 q = *(const LAS f32x4*)(red + rl * 4); const float tot = ((q[0] + q[1]) + (q[2] + q[3])) * (s * s);
                f32x4 a0 = acc[ai][0][m][0] * s, a1 = acc[ai][0][m][1] * s, b0 = acc[ai][1][m][0] * s, b1 = acc[ai][1][m][1] * s;
                if (pn == 0) { const float rn = 1.f / sqrtf(tot * (1.f / KVRANK) + EPS);
                    st8(CKV + (size_t)p * KVRANK + c, a0 * rn, a1 * rn); st8(CKV + (size_t)p * KVRANK + 128 + c, b0 * rn, b1 * rn); }
                else if (pn == 1) { st8(CQ + (size_t)p * QRANK + c, a0, a1); st8(CQ + (size_t)p * QRANK + 128 + c, b0, b1); if (wc == 0 && fq == 0) sscq[(size_t)p * 2] = tot; }
                else { if (wc == 0 && fq == 0) sscq[(size_t)p * 2 + 1] = tot;
                    if (wc < 3) { st8(CQ + (size_t)p * QRANK + 256 + c, a0, a1); if (wc == 0) st8(CQ + (size_t)p * QRANK + 352 + c, b0, b1); }
                    else { f32x4 o1a, o1b, o2a, o2b; rope8(rope + ((size_t)p * 32 + 8 * fq) * 2, a0, a1, b0, b1, o1a, o1b, o2a, o2b); krope_store8(K8, p, 8 * fq, o1a, o1b, o2a, o2b); } }
                asm volatile("" ::: "memory"); }
        __syncthreads();
    }
};
struct EpiKvUp {
    bf16* Kb; bf16* Vb;
    __device__ __forceinline__ void row(int p, int pn, int wc, int fq, f32x4 a0, f32x4 a1, f32x4 b0, f32x4 b1, bool valid) const {
        if (!valid) return;
        const int c = 32 * wc + 8 * fq;
        st8(Kb + ((size_t)pn * KROWS + p + KPAD) * DQK + c, a0, a1);
        st8(Vb + ((size_t)pn * KROWS + p + KPAD) * DV + c, b0, b1);
    }
};
struct EpiQUp {
    bf16* Qb; const float* sscq; const float* rope;
    __device__ __forceinline__ void row(int p, int pn, int wc, int fq, f32x4 a0, f32x4 a1, f32x4 b0, f32x4 b1, bool valid) const {
        if (!valid) return;
        const float* q = sscq + (size_t)p * 2; const float s = QSCALE / sqrtf((q[0] + q[1]) * (1.f / QRANK) + EPS);
        const int qr = p - NMETA;
        a0 = a0 * s; a1 = a1 * s; b0 = b0 * s; b1 = b1 * s;
        if (pn < 4) { const int c = 32 * wc + 8 * fq;
            st8(Qb + ((size_t)(2 * pn) * SEQ + qr) * DQK + c, a0, a1); st8(Qb + ((size_t)(2 * pn + 1) * SEQ + qr) * DQK + c, b0, b1); }
        else { const int h = 4 * (pn - 4) + wc, i0 = 8 * fq;
            f32x4 o1a, o1b, o2a, o2b; rope8(rope + ((size_t)p * 32 + i0) * 2, a0, a1, b0, b1, o1a, o1b, o2a, o2b);
            bf16* qp = Qb + ((size_t)h * SEQ + qr) * DQK + 128;
            st8(qp + i0, o1a, o1b); st8(qp + 32 + i0, o2a, o2b); }
    }
};

constexpr float K8SCALE = 0.25f, Q8SCALE = 4.f;
constexpr float WO8SCALE = 32.f, O8SCALE = 16.f, WGU8SCALE = 32.f, HH8SCALE = 4.f, WD8SCALE = 16.f, YS8SCALE = 16.f;
__device__ __forceinline__ unsigned pk4_fp8(float a, float b, float c, float d) { int w = 0; w = __builtin_amdgcn_cvt_pk_fp8_f32(a, b, w, false); w = __builtin_amdgcn_cvt_pk_fp8_f32(c, d, w, true); return (unsigned)w; }
__device__ __forceinline__ u32x2 pk8_fp8(f32x4 a, f32x4 b) { u32x2 w; w.x = pk4_fp8(a[0], a[1], a[2], a[3]); w.y = pk4_fp8(b[0], b[1], b[2], b[3]); return w; }
__device__ __forceinline__ int vt_slot(int kk) { const int k5 = kk & 31; return 32 * ((k5 >> 2) & 1) + ((kk & 32) >> 1) + 4 * (k5 >> 3) + (k5 & 3); }
__device__ __forceinline__ void krope_store8(unsigned char* K8, int p, int i0, f32x4 o1a, f32x4 o1b, f32x4 o2a, f32x4 o2b) {
    const u32x2 w1 = pk8_fp8(o1a * K8SCALE, o1b * K8SCALE), w2 = pk8_fp8(o2a * K8SCALE, o2b * K8SCALE);
#pragma unroll
    for (int h = 0; h < NH; ++h) { *(u32x2*)(K8 + k8_off(h, p + KPAD, 128 + i0)) = w1; *(u32x2*)(K8 + k8_off(h, p + KPAD, 160 + i0)) = w2; }
}
struct EpiKnope8 {
    unsigned char* K8;
    __device__ __forceinline__ void row(int p, int pn, int wc, int fq, f32x4 a0, f32x4 a1, f32x4 b0, f32x4 b1, bool valid) const {
        if (!valid) return;
        const int c = 32 * wc + 8 * fq;
        *(u32x2*)(K8 + k8_off(2 * pn, p + KPAD, c)) = pk8_fp8(a0 * K8SCALE, a1 * K8SCALE);
        *(u32x2*)(K8 + k8_off(2 * pn + 1, p + KPAD, c)) = pk8_fp8(b0 * K8SCALE, b1 * K8SCALE);
    }
};
struct EpiVt8 {
    static constexpr bool PERM2 = true;
    unsigned char* Vt8;
    __device__ __forceinline__ void row(int r, int pn, int wc, int fq, f32x4 a0, f32x4 a1, f32x4 b0, f32x4 b1, bool valid) const {
        if (!valid) return;
        const int hh = r >> 7, d = r & 127;
#pragma unroll
        for (int hf = 0; hf < 2; ++hf) { const int n0 = 256 * pn + 128 * hf + 32 * wc + 4 * (fq & 1) + 16 * (fq >> 1), T = (n0 >> 6) + 1, kk0 = n0 & 63;
            unsigned char* base = Vt8 + vt8_off(hh, T, d, vt_slot(kk0));
            const f32x4 lo = hf ? b0 : a0, hi = hf ? b1 : a1;
            u32x2 w; w.x = pk4_fp8(lo[0], lo[1], lo[2], lo[3]); w.y = pk4_fp8(hi[0], hi[1], hi[2], hi[3]); *(u32x2*)base = w; }
    }
};
struct EpiVt8Meta {
    unsigned char* Vt8;
    __device__ __forceinline__ void row(int p, int pn, int wc, int fq, f32x4 a0, f32x4 a1, f32x4 b0, f32x4 b1, bool valid) const {
        if (!valid) return;
        const int slot = vt_slot(KPAD + p);
#pragma unroll
        for (int hf = 0; hf < 2; ++hf) { const int hh = 2 * pn + hf, d0 = 32 * wc + 8 * fq;
#pragma unroll
            for (int j = 0; j < 8; ++j) { const float v = hf ? (j < 4 ? b0[j] : b1[j - 4]) : (j < 4 ? a0[j] : a1[j - 4]);
                Vt8[vt8_off(hh, 0, d0 + j, slot)] = (unsigned char)(__builtin_amdgcn_cvt_pk_fp8_f32(v, v, 0, false) & 0xff); } }
    }
};
__device__ __forceinline__ size_t q8_off(int h, int qr, int col) { return ((size_t)h * SEQ + (qr & ~31)) * DQK + (size_t)((col >> 5) * 1024 + (qr & 31) * 32 + (col & 31)); }
struct EpiQUp8 {
    unsigned char* Q8; const float* sscq; const float* rope;
    __device__ __forceinline__ void row(int p, int pn, int wc, int fq, f32x4 a0, f32x4 a1, f32x4 b0, f32x4 b1, bool valid) const {
        if (!valid) return;
        const float* q = sscq + (size_t)p * 2; const float s = (QSCALE * Q8SCALE) / sqrtf((q[0] + q[1]) * (1.f / QRANK) + EPS);
        const int qr = p - NMETA;
        a0 = a0 * s; a1 = a1 * s; b0 = b0 * s; b1 = b1 * s;
        if (pn < 4) { const int c = 32 * wc + 8 * fq;
            *(u32x2*)(Q8 + q8_off(2 * pn, qr, c)) = pk8_fp8(a0, a1); *(u32x2*)(Q8 + q8_off(2 * pn + 1, qr, c)) = pk8_fp8(b0, b1); }
        else { const int h = 4 * (pn - 4) + wc, i0 = 8 * fq;
            f32x4 o1a, o1b, o2a, o2b; rope8(rope + ((size_t)p * 32 + i0) * 2, a0, a1, b0, b1, o1a, o1b, o2a, o2b);
            *(u32x2*)(Q8 + q8_off(h, qr, 128 + i0)) = pk8_fp8(o1a, o1b); *(u32x2*)(Q8 + q8_off(h, qr, 160 + i0)) = pk8_fp8(o2a, o2b); }
    }
};

__device__ __forceinline__ void tr_item(const float* src, int ld, int col0, const float* gain, int k0, bf16* dst, int Kd, LAS float* scr, int lane, float f8scale = 0.f) {
    (void)scr;
    const int g = lane >> 3, q = lane & 7;
    if (f8scale > 0.f) { unsigned char* d8 = (unsigned char*)dst + (size_t)(4 * q) * Kd + k0 + 8 * g;
        if (col0 < 0) {
#pragma unroll
            for (int j = 0; j < 4; ++j) *(u32x2*)(d8 + (size_t)j * Kd) = (u32x2){0u, 0u};
            return; }
        f32x4 v[8]; const float* sp = src + (size_t)(k0 + 8 * g) * ld + col0 + 4 * q;
#pragma unroll
        for (int i = 0; i < 8; ++i) v[i] = *(const f32x4*)(sp + (size_t)i * ld) * f8scale;
        if (gain) { const f32x4 g0 = *(const f32x4*)(gain + k0 + 8 * g), g1 = *(const f32x4*)(gain + k0 + 8 * g + 4);
#pragma unroll
            for (int i = 0; i < 4; ++i) { v[i] = v[i] * g0[i]; v[4 + i] = v[4 + i] * g1[i]; } }
#pragma unroll
        for (int j = 0; j < 4; ++j) { u32x2 o; o.x = pk4_fp8(v[0][j], v[1][j], v[2][j], v[3][j]); o.y = pk4_fp8(v[4][j], v[5][j], v[6][j], v[7][j]); *(u32x2*)(d8 + (size_t)j * Kd) = o; }
        return; }
    bf16* dp = dst + (size_t)(4 * q) * Kd + k0 + 8 * g;
    if (col0 < 0) {
#pragma unroll
        for (int j = 0; j < 4; ++j) *(u32x4*)(dp + (size_t)j * Kd) = (u32x4){0u, 0u, 0u, 0u};
        return;
    }
    f32x4 v[8];
    const float* sp = src + (size_t)(k0 + 8 * g) * ld + col0 + 4 * q;
#pragma unroll
    for (int i = 0; i < 8; ++i) v[i] = *(const f32x4*)(sp + (size_t)i * ld);
    if (gain) { const f32x4 g0 = *(const f32x4*)(gain + k0 + 8 * g), g1 = *(const f32x4*)(gain + k0 + 8 * g + 4);
#pragma unroll
        for (int i = 0; i < 4; ++i) { v[i] = v[i] * g0[i]; v[4 + i] = v[4 + i] * g1[i]; } }
#pragma unroll
    for (int j = 0; j < 4; ++j) { u32x4 o; o.x = cvtpk(v[0][j], v[1][j]); o.y = cvtpk(v[2][j], v[3][j]); o.z = cvtpk(v[4][j], v[5][j]); o.w = cvtpk(v[6][j], v[7][j]);
        *(u32x4*)(dp + (size_t)j * Kd) = o; }
}
constexpr int IT_GU = 16 * 16, IT_D = 32 * 4, IT_EXP = IT_GU + IT_D;
constexpr int L0_PRO = 0, L0_P1 = 40, L1_P5 = 32, L1_P8 = 12, L1_P12 = 20;
__device__ __forceinline__ void expert_item(const Frame& F, int r, LAS float* scr, int lane) {
    const int le = r / IT_EXP, q = r % IT_EXP, l = le >> 6;
    if (q < IT_GU) { const int nb = q >> 4, kb = q & 15, n0 = nb * 32, pn = n0 >> 8, hf = (n0 >> 7) & 1, c = n0 & 127;
        bf16* dst8 = (bf16*)((unsigned char*)F_WGU + ((size_t)le * 512 + n0) * 1024);
        if (hf) tr_item(FIN(I_WUP) + (size_t)le * 1024 * 256, 256, 128 * pn + c, FIN(I_GFFN) + l * D, kb * 64, dst8, 1024, scr, lane, WGU8SCALE);
        else tr_item(FIN(I_WGATE) + (size_t)le * 1024 * 256, 256, 128 * pn + c, FIN(I_GFFN) + l * D, kb * 64, dst8, 1024, scr, lane, WGU8SCALE); }
    else { const int q2 = q - IT_GU, nb = q2 >> 2, kb = q2 & 3;
        tr_item(FIN(I_WDOWN) + (size_t)le * 256 * 1024, 1024, nb * 32, nullptr, kb * 64, (bf16*)((unsigned char*)F_WD + ((size_t)le * 1024 + nb * 32) * 256), 256, scr, lane, WD8SCALE); }
}
__device__ __forceinline__ void p0_prologue(const Frame& F) {
    LAS float* scr = (LAS float*)(F.lds + F.wave * 16384);
    const int lane = (opq(F.tid) & 63);
    constexpr int IT_WIN = 96 * 16, IT_WOUT = 32 * 16, IT_WO = 32 * 16, IT_KVQ = 24 * 16, IT_UKV = 64 * 4, IT_UQ = 48 * 6;
    constexpr int IT_SMALL = IT_WIN + IT_WOUT + IT_WO + IT_KVQ + IT_UKV + IT_UQ;
    const int IT_ALL = IT_SMALL + (gridDim.x >= 256 ? L0_PRO : L0_PRO + L0_P1) * IT_EXP;
    for (int it = F.gw; it < IT_ALL; it += F.ngw) {
        int r = it;
        if (r < IT_WIN) { const int nb = r >> 4, kb = r & 15, n0 = nb * 32, pn = n0 >> 8, hf = (n0 >> 7) & 1, c = n0 & 127;
            const int col = (pn < 4) ? (256 * pn + 128 * hf + c) : ((hf ? 2048 : 1024) + 128 * (pn - 4) + c);
            tr_item(FIN(I_WIN), 3072, col, FIN(I_GMIX), kb * 64, F_WIN + (size_t)n0 * 1024, 1024, scr, lane); continue; } r -= IT_WIN;
        if (r < IT_WOUT) { const int nb = r >> 4, kb = r & 15; tr_item(FIN(I_WOUT), 1024, nb * 32, nullptr, kb * 64, F_WOUT + (size_t)nb * 32 * 1024, 1024, scr, lane); continue; } r -= IT_WOUT;
        if (r < IT_WO) { const int nb = r >> 4, kb = r & 15; tr_item(FIN(I_WO), 1024, nb * 32, nullptr, kb * 64, (bf16*)((unsigned char*)F_WO + (size_t)nb * 32 * 1024), 1024, scr, lane, WO8SCALE); continue; } r -= IT_WO;
        if (r < IT_KVQ) { const int nb = r >> 4, kb = r & 15, n0 = nb * 32; bf16* dst = F_WKVQ + (size_t)n0 * 1024;
            const float* gq = FIN(I_GMIX) + D;
            if (n0 < 256) tr_item(FIN(I_WDKV), 320, n0, FIN(I_KVG), kb * 64, dst, 1024, scr, lane);
            else if (n0 < 512) tr_item(FIN(I_WDQ), 384, n0 - 256, gq, kb * 64, dst, 1024, scr, lane);
            else { const int w = n0 - 512, hf = w >> 7, c = w & 127;
                if (hf == 0) { if (c < 96) tr_item(FIN(I_WDQ), 384, 256 + c, gq, kb * 64, dst, 1024, scr, lane); else tr_item(FIN(I_WDKV), 320, 256, FIN(I_KVG), kb * 64, dst, 1024, scr, lane); }
                else { if (c < 32) tr_item(FIN(I_WDQ), 384, 352, gq, kb * 64, dst, 1024, scr, lane); else if (c < 96) tr_item(FIN(I_WDQ), 384, -1, nullptr, kb * 64, dst, 1024, scr, lane); else tr_item(FIN(I_WDKV), 320, 288, FIN(I_KVG), kb * 64, dst, 1024, scr, lane); } }
            continue; } r -= IT_KVQ;
        if (r < IT_UKV) { const int nb = r >> 2, kb = r & 3, n0 = nb * 32, hh = n0 >> 8, w = n0 & 255;
            tr_item(FIN(I_WUKV), 2048, n0, FIN(I_CKVG), kb * 64, (w < 128 ? F_WK : F_WV) + (size_t)(hh * 128 + (w & 127)) * 256, 256, scr, lane); continue; } r -= IT_UKV;
        if (r < IT_UQ) { const int nb = r / 6, kb = r % 6, n0 = nb * 32; int col;
            if (n0 < 1024) { const int pn = n0 >> 8, hf = (n0 >> 7) & 1, c = n0 & 127; col = (2 * pn + hf) * 192 + c; }
            else { const int w = n0 - 1024, t = w >> 8, hf = (w >> 7) & 1, c = w & 127, hh = c >> 5; col = (4 * t + hh) * 192 + 128 + 32 * hf; }
            tr_item(FIN(I_WUQ), 1536, col, FIN(I_CQG), kb * 64, F_WUQ + (size_t)n0 * 384, 384, scr, lane); continue; } r -= IT_UQ;
        expert_item(F, r, scr, lane);
    }
    { const int gt = F.gw * 64 + lane, ngt = F.ngw * 64;
      for (int idx = gt; idx < 2 * 96 * 1024; idx += ngt) { const int l = idx / (96 * 1024), rem = idx % (96 * 1024), n = rem >> 10, k = rem & 1023;
          float v = 0.f; if (n < 8) v = FIN(I_WGRP)[((size_t)l * 1024 + k) * 8 + n]; else if (n < 72) v = FIN(I_WEXP)[((size_t)l * 1024 + k) * 64 + (n - 8)];
          v *= FIN(I_GFFN)[l * D + k]; F_WR[idx] = (bf16)(cvtpk(v, 0.f) & 0xffffu); }
      for (int idx = gt; idx < T * 32; idx += ngt) { const int p = idx >> 5, i = idx & 31; const float ang = (float)p * ROPE_INV[i];
          const double rev = (double)ang * 0.15915494309189535; const float fr = (float)(rev - __builtin_rint(rev));
          F_ROPE[2 * idx] = __builtin_amdgcn_cosf(fr); F_ROPE[2 * idx + 1] = __builtin_amdgcn_sinf(fr); } }
    for (int p = F.gw; p < T; p += F.ngw) { const float* src = (p < NMETA) ? FIN(I_META) + (size_t)p * D : FIN(I_X) + (size_t)(p - NMETA) * D;
        f32x4 v[4]; float s = 0.f;
#pragma unroll
        for (int j = 0; j < 4; ++j) { v[j] = *(const f32x4*)(src + 4 * lane + 256 * j); s += (v[j][0] * v[j][0] + v[j][1] * v[j][1]) + (v[j][2] * v[j][2] + v[j][3] * v[j][3]); }
        s = wave_sum(s);
#pragma unroll
        for (int j = 0; j < 4; ++j) { u32x2 w; w.x = cvtpk(v[j][0], v[j][1]); w.y = cvtpk(v[j][2], v[j][3]); *(u32x2*)(F_H0B + (size_t)p * D + 4 * lane + 256 * j) = w; }
        if (lane == 0) F_STAT[ST_RSTD0 + p] = 1.f / sqrtf(s * (1.f / D) + EPS); }
}

__device__ __forceinline__ void conv_phase(const Frame& F) {
    const int lane = (opq(F.tid) & 63), c0 = lane * 16;
    float cw[3][16];
#pragma unroll
    for (int t = 0; t < 3; ++t)
#pragma unroll
        for (int j = 0; j < 16; ++j) cw[t][j] = FIN(I_CONVW)[t * D + c0 + j];
    for (int p = F.gw; p < T; p += F.ngw) {
#pragma unroll
        for (int hf = 0; hf < 2; ++hf) { const int c = c0 + 8 * hf;
            float z0[8], z1[8], z2[8], b[8];
            unpack8(*(const u32x4*)(F_ZB + (size_t)p * D + c), z2); unpack8(*(const u32x4*)(F_BB + (size_t)p * D + c), b);
            if (p >= 1) unpack8(*(const u32x4*)(F_ZB + (size_t)(p - 1) * D + c), z1); else { for (int j = 0; j < 8; ++j) z1[j] = 0.f; }
            if (p >= 2) unpack8(*(const u32x4*)(F_ZB + (size_t)(p - 2) * D + c), z0); else { for (int j = 0; j < 8; ++j) z0[j] = 0.f; }
            float o[8];
#pragma unroll
            for (int j = 0; j < 8; ++j) o[j] = b[j] * (cw[0][8 * hf + j] * z0[j] + cw[1][8 * hf + j] * z1[j] + cw[2][8 * hf + j] * z2[j]);
            *(u32x4*)(F_A2 + (size_t)p * D + c) = pack8((f32x4){o[0], o[1], o[2], o[3]}, (f32x4){o[4], o[5], o[6], o[7]}); }
    }
}

constexpr int RT_ROWB = 1040, RT_SCR = 80 * RT_ROWB, RT_LCNT = MISC_OFF + 1024;
__device__ __forceinline__ void router_phase(const Frame& F, const bf16* Hb, const bf16* Wr, float* rstd_out, unsigned* cnt, int p_lo, int host_first, int host_n) {
    const int tid = opq(F.tid), lane = tid & 63, fr = lane & 15, fq = lane >> 4;
    const int nblk = (T - p_lo + 15) / 16;
    if ((int)blockIdx.x * NWAVES >= nblk) {
        { const int first = (nblk + NWAVES - 1) / NWAVES, nfree = (int)gridDim.x - first, rank = (int)blockIdx.x - first;
            for (int it = rank * NWAVES + F.wave; it < host_n; it += nfree * NWAVES) expert_item(F, host_first + it, nullptr, lane); }
        return; }
    const int blk = blockIdx.x * NWAVES + F.wave;
    const int p = p_lo + blk * 16 + fr; const bool valid = (blk < nblk) && (p < T); const int pc = valid ? p : T - 1;
    LAS float* scr = (LAS float*)(F.lds + RT_SCR + F.wave * 5376);
    LAS int* lcnt = (LAS int*)(F.lds + RT_LCNT); LAS int* lbase = lcnt + 64;
    if (tid < 64) lcnt[tid] = 0;
    f32x4 acc[5]; float ss = 0.f;
#pragma unroll
    for (int n = 0; n < 5; ++n) acc[n] = (f32x4){0.f, 0.f, 0.f, 0.f};
    const bf16* arow = Hb + (size_t)pc * D + fq * 8;
#pragma unroll 1
    for (int half = 0; half < 2; ++half) {
        bf16x8 a[16];
#pragma unroll
        for (int ks = 0; ks < 16; ++ks) a[ks] = *(const bf16x8*)(arow + half * 512 + ks * 32);
        __syncthreads();
#pragma unroll
        for (int i = 0; i < 10; ++i) { const int id = tid + NTHREADS * i, row = id >> 6, ch = id & 63;
            *(LAS u32x4*)(F.lds + row * RT_ROWB + ch * 16) = *(const u32x4*)(Wr + (size_t)row * D + half * 512 + ch * 8); }
        __syncthreads();
#pragma unroll
        for (int ks = 0; ks < 16; ++ks) {
            float av[8]; unpack8(__builtin_bit_cast(u32x4, a[ks]), av);
#pragma unroll
            for (int t = 0; t < 8; ++t) ss += av[t] * av[t];
#pragma unroll
            for (int n = 0; n < 5; ++n) { const bf16x8 b = *(const LAS bf16x8*)(F.lds + (16 * n + fr) * RT_ROWB + ks * 64 + fq * 16); acc[n] = __builtin_amdgcn_mfma_f32_16x16x32_bf16(b, a[ks], acc[n], 0, 0, 0); }
        }
    }
    ss += __shfl_xor(ss, 16); ss += __shfl_xor(ss, 32);
    const float rs = 1.f / sqrtf(ss * (1.f / D) + EPS);
#pragma unroll
    for (int n = 0; n < 5; ++n)
#pragma unroll
        for (int t = 0; t < 4; ++t) scr[fr * 84 + 16 * n + 4 * fq + t] = acc[n][t] * rs;
    LDS_WAIT();
    int ea = 0, eb = 0, ra = 0, rb = 0; float w0 = 0.f, w1 = 0.f;
    const bool sel = valid && lane < 16;
    if (lane < 16) {
        const LAS float* L = scr + lane * 84;
        int g = 0; float mg = L[0];
#pragma unroll
        for (int j = 1; j < 8; ++j) { const float v = L[j]; if (v > mg) { mg = v; g = j; } }
        float sg = 0.f;
#pragma unroll
        for (int j = 0; j < 8; ++j) sg += expf(L[j] - mg);
        const float pg = 1.f / sg;
        const LAS float* Le = L + 8 + g * 8;
        int i0 = 0; float m0 = Le[0];
#pragma unroll
        for (int j = 1; j < 8; ++j) { const float v = Le[j]; if (v > m0) { m0 = v; i0 = j; } }
        int i1 = 0; float m1 = -__builtin_inff();
#pragma unroll
        for (int j = 0; j < 8; ++j) { const float v = Le[j]; if (j != i0 && v > m1) { m1 = v; i1 = j; } }
        const float e1 = expf(m1 - m0); w0 = pg / (1.f + e1); w1 = pg * e1 / (1.f + e1);
        ea = g * 8 + i0; eb = g * 8 + i1;
        if (sel) { ra = __hip_atomic_fetch_add(&lcnt[ea], 1, __ATOMIC_RELAXED, __HIP_MEMORY_SCOPE_WORKGROUP); rb = __hip_atomic_fetch_add(&lcnt[eb], 1, __ATOMIC_RELAXED, __HIP_MEMORY_SCOPE_WORKGROUP); }
    }
    __syncthreads();
    if (tid < 64) { const int c = lcnt[tid]; lbase[tid] = c > 0 ? (int)atomicAdd(&cnt[tid], (unsigned)c) : 0; }
    __syncthreads();
    if (sel) {
        rstd_out[p] = rs;
        const unsigned sa = (unsigned)(lbase[ea] + ra), sb = (unsigned)(lbase[eb] + rb);
        F_TOK[(size_t)ea * CAP + sa] = p; F_WOF[(size_t)ea * CAP + sa] = w0;
        F_TOK[(size_t)eb * CAP + sb] = p; F_WOF[(size_t)eb * CAP + sb] = w1;
        F_TSLOT[2 * p] = ((unsigned)ea << 16) | sa; F_TSLOT[2 * p + 1] = ((unsigned)eb << 16) | sb;
    }
    __syncthreads();
}

__device__ __forceinline__ void moe_tables(const Frame& F, const unsigned* cnt) {
    LAS int* cn = (LAS int*)(F.lds + MISC_OFF + 256); LAS int* pb = cn + 64;
    __syncthreads();
    if (F.tid < 64) cn[F.tid] = (int)__hip_atomic_load(cnt + F.tid, __ATOMIC_RELAXED, __HIP_MEMORY_SCOPE_AGENT);
    __syncthreads();
    if (F.tid == 0) { int s = 0; for (int e = 0; e < NE; ++e) { pb[e] = s; s += (cn[e] + 255) >> 8; } pb[NE] = s; }
    __syncthreads();
}
__device__ __forceinline__ int moe_find(const LAS int* pb, int panel) { int e = 0; while (e < NE - 1 && pb[e + 1] <= panel) ++e; return e; }


constexpr int MOE_REC = MISC_OFF + 1024, MOE_TAB = MISC_OFF + 2048, MOE_SLOTS = 4;
struct MoeOrder {
    const LAS int* rec; const bf16* W; size_t estride; int K;
    __device__ __forceinline__ bool next(int i, pg8::MUnit& u) const {
        if (i >= MOE_SLOTS) return false; const LAS int* r = rec + 4 * i; if (r[3] == 0) return false;
        u.pm = r[0]; u.pn = r[1]; u.slot = i; u.bt = W + (size_t)r[2] * estride + (size_t)r[1] * 256 * K; return true; }
};
template <bool GU>
__device__ __forceinline__ void moe_fill(const Frame& F, int vcu, const float* rstd) {
    const LAS int* cn = (const LAS int*)(F.lds + MISC_OFF + 256); const LAS int* pb = cn + 64;
    LAS int* rec = (LAS int*)(F.lds + MOE_REC);
    const int npn = GU ? 2 : 4, nunits = pb[NE] * npn, tid = opq(F.tid);
    for (int s = 0; s < MOE_SLOTS; ++s) {
        const int L = s * (int)gridDim.x + vcu;
        if (L >= nunits) { if (tid == 0) rec[4 * s + 3] = 0; continue; }
        const int panel = L / npn, pn = L % npn, e = moe_find(pb, panel);
        if (tid == 0) { rec[4 * s] = panel; rec[4 * s + 1] = pn; rec[4 * s + 2] = e; rec[4 * s + 3] = 1; }
        if (tid < 256) { const int i = (panel - pb[e]) * 256 + tid; const bool valid = i < cn[e];
            LAS unsigned* ro = (LAS unsigned*)(F.lds + MOE_TAB + s * 2048); LAS float* sc = (LAS float*)(ro + 256);
            if (GU) { const int tok = valid ? F_TOK[(size_t)e * CAP + i] : 0; ro[tid] = (unsigned)tok * (unsigned)D; sc[tid] = valid ? rstd[tok] * (1.f / WGU8SCALE) : -1.f; }
            else { ro[tid] = 0u; sc[tid] = valid ? F_WOF[(size_t)e * CAP + i] * (YS8SCALE / (HH8SCALE * WD8SCALE)) : -1.f; } }
    }
    __syncthreads();
}
struct EpiMoeGU {
    static constexpr bool PERM = true, AFTER_DRAIN = false;
    bf16* HH; const LAS float* tab;
    __device__ __forceinline__ void operator()(const f32x4 (&acc)[2][2][4][2], const pg8::MUnit& u, int wr, int wc, int fr, int fq) const {
#pragma unroll
        for (int ai = 0; ai < 2; ++ai)
#pragma unroll
            for (int m = 0; m < 4; ++m) { const int rl = ai * 128 + wr * 64 + m * 16 + fr; const float s = tab[u.slot * 512 + 256 + rl];
                if (s > 0.f) { f32x4 o[2];
#pragma unroll
                    for (int n = 0; n < 2; ++n)
#pragma unroll
                        for (int j = 0; j < 4; ++j) { const float gg = acc[ai][0][m][n][j] * s, uu = acc[ai][1][m][n][j] * s; o[n][j] = gg * __builtin_amdgcn_rcpf(1.f + __expf(-gg)) * uu; }
                    *(u32x2*)((unsigned char*)HH + ((size_t)u.pm * 256 + rl) * DE + 128 * u.pn + 32 * wc + 8 * fq) = pk8_fp8(o[0] * HH8SCALE, o[1] * HH8SCALE); } }
    }
};
struct EpiMoeDown {
    static constexpr bool PERM = true, AFTER_DRAIN = false;
    bf16* YS; const LAS float* tab;
    __device__ __forceinline__ void operator()(const f32x4 (&acc)[2][2][4][2], const pg8::MUnit& u, int wr, int wc, int fr, int fq) const {
#pragma unroll
        for (int ai = 0; ai < 2; ++ai)
#pragma unroll
            for (int m = 0; m < 4; ++m) { const int rl = ai * 128 + wr * 64 + m * 16 + fr; const float w = tab[u.slot * 512 + 256 + rl];
                if (w > 0.f) { unsigned char* yp = (unsigned char*)YS + ((size_t)u.pm * 256 + rl) * D + 256 * u.pn + 32 * wc + 8 * fq;
                    *(u32x2*)yp = pk8_fp8(acc[ai][0][m][0] * w, acc[ai][0][m][1] * w); *(u32x2*)(yp + 128) = pk8_fp8(acc[ai][1][m][0] * w, acc[ai][1][m][1] * w); } }
    }
};
__device__ __forceinline__ int frame_vcu() { const int G = (int)gridDim.x, bx = (int)blockIdx.x; return (G % 8 == 0) ? (bx % 8) * (G / 8) + bx / 8 : bx; }
__device__ __forceinline__ void moe_gu_fast(const Frame& F, const bf16* Hb, const float* rstd, int layer) {
    moe_fill<true>(F, frame_vcu(), rstd);
    const MoeOrder S{(const LAS int*)(F.lds + MOE_REC), F_WGU + (size_t)layer * NE * 512 * 512, (size_t)512 * 512, 512};
    const EpiMoeGU E{F_HH, (const LAS float*)(F.lds + MOE_TAB)};
    pg8::gemm_phase_moe<EpiMoeGU, MoeOrder, true, true, true>(F.lds, (const bf16*)F_H8, 512, S, E, (const LAS unsigned*)(F.lds + MOE_TAB), 512);
    if (layer == 0) {
        const LAS int* pb = (const LAS int*)(F.lds + MISC_OFF + 256) + 64;
        const int G = (int)gridDim.x, nun = pb[NE] * 2, vcu = frame_vcu();
        const int first_free = nun > G ? (nun - G < G ? nun - G : G) : (nun < G ? nun : G);
        int nfree = G - first_free, rank = vcu - first_free;
        if (nfree <= 0) { nfree = G; rank = vcu; }
        if (rank >= 0) { const int lane = opq(F.tid) & 63;
            for (int it = rank * NWAVES + F.wave; it < L1_P5 * IT_EXP; it += nfree * NWAVES) expert_item(F, NE * IT_EXP + it, nullptr, lane); }
    }
}
__device__ __forceinline__ void moe_down_fast(const Frame& F, int layer) {
    moe_fill<false>(F, frame_vcu(), nullptr);
    const MoeOrder S{(const LAS int*)(F.lds + MOE_REC), F_WD + (size_t)layer * NE * 1024 * 128, (size_t)1024 * 128, 128};
    const EpiMoeDown E{F_YS, (const LAS float*)(F.lds + MOE_TAB)};
    pg8::gemm_phase_moe<EpiMoeDown, MoeOrder, true, false, true>(F.lds, F_HH, 128, S, E, (const LAS unsigned*)(F.lds + MOE_TAB), 512);
}

template <bool FINAL>
__device__ __forceinline__ void combine_phase(const Frame& F, const bf16* Hin, bf16* Hout, float* rstd_out, int p_lo) {
    const LAS int* pb = (const LAS int*)(F.lds + MISC_OFF + 256) + 64;
    const int lane = (opq(F.tid) & 63), c0 = lane * 16;
    for (int p = p_lo + F.gw; p < T; p += F.ngw) {
        const unsigned s0 = F_TSLOT[2 * p], s1 = F_TSLOT[2 * p + 1];
        const size_t r0 = (size_t)pb[s0 >> 16] * 256 + (s0 & 0xffffu), r1 = (size_t)pb[s1 >> 16] * 256 + (s1 & 0xffffu);
        float v[16]; float ss = 0.f;
        const u32x4 q0 = *(const u32x4*)((const unsigned char*)F_YS + r0 * D + c0), q1 = *(const u32x4*)((const unsigned char*)F_YS + r1 * D + c0);
        float y[16];
#pragma unroll
        for (int w = 0; w < 4; ++w) { const unsigned a_ = q0[w], b_ = q1[w];
            y[4 * w] = __builtin_amdgcn_cvt_f32_fp8(a_, 0) + __builtin_amdgcn_cvt_f32_fp8(b_, 0); y[4 * w + 1] = __builtin_amdgcn_cvt_f32_fp8(a_, 1) + __builtin_amdgcn_cvt_f32_fp8(b_, 1);
            y[4 * w + 2] = __builtin_amdgcn_cvt_f32_fp8(a_, 2) + __builtin_amdgcn_cvt_f32_fp8(b_, 2); y[4 * w + 3] = __builtin_amdgcn_cvt_f32_fp8(a_, 3) + __builtin_amdgcn_cvt_f32_fp8(b_, 3); }
#pragma unroll
        for (int hf = 0; hf < 2; ++hf) { float a[8];
            unpack8(*(const u32x4*)(Hin + (size_t)p * D + c0 + 8 * hf), a);
#pragma unroll
            for (int j = 0; j < 8; ++j) { const float t = a[j] + y[8 * hf + j] * (1.f / YS8SCALE); v[8 * hf + j] = t; ss += t * t; } }
        ss = wave_sum(ss);
        const float rs = 1.f / sqrtf(ss * (1.f / D) + EPS);
        if constexpr (FINAL) {
            float* o = F.P->out + (size_t)(p - NMETA) * D + c0; const float* fg = FIN(I_FG) + c0;
#pragma unroll
            for (int j = 0; j < 4; ++j) { const f32x4 g4 = *(const f32x4*)(fg + 4 * j); *(f32x4*)(o + 4 * j) = (f32x4){v[4 * j] * rs * g4[0], v[4 * j + 1] * rs * g4[1], v[4 * j + 2] * rs * g4[2], v[4 * j + 3] * rs * g4[3]}; }
        } else {
            *(u32x4*)(Hout + (size_t)p * D + c0) = pack8((f32x4){v[0], v[1], v[2], v[3]}, (f32x4){v[4], v[5], v[6], v[7]});
            *(u32x4*)(Hout + (size_t)p * D + c0 + 8) = pack8((f32x4){v[8], v[9], v[10], v[11]}, (f32x4){v[12], v[13], v[14], v[15]});
            if (lane == 0) rstd_out[p] = rs;
        }
    }
}


typedef int v8i __attribute__((ext_vector_type(8)));
#define MFMA_F8(A, B, C, AFMT) __builtin_amdgcn_mfma_scale_f32_32x32x64_f8f6f4((A), (B), (C), (AFMT), 0, 0, 0x7f7f7f7f, 0, 0x7f7f7f7f)
__device__ __forceinline__ v8i ld32(const unsigned char* p) { const u32x4 a = *(const u32x4*)p, b = *(const u32x4*)(p + 16); return (v8i){(int)a.x, (int)a.y, (int)a.z, (int)a.w, (int)b.x, (int)b.y, (int)b.z, (int)b.w}; }
namespace att8 {
typedef __attribute__((address_space(3))) const char* lds_cptr;
constexpr int KT = 12288, VT = 8192;
constexpr int L_K = 0, L_V = 3 * KT, L_WS = L_V + 4 * VT, L_OST = L_WS + NWAVES * 256, L_END = L_OST + NWAVES * 4096;
constexpr float BIAS8 = 0.f, THR8 = 15.f;
#define ATT_SBAR() __builtin_amdgcn_sched_barrier(0)
#define ATT_WAIT_BAR(N) asm volatile("s_waitcnt vmcnt(" #N ") lgkmcnt(0)\n\ts_barrier" ::: "memory")
__device__ __forceinline__ void glds16s(const void* sbase, unsigned voff, unsigned lds_dst) { unsigned keep;
    asm volatile("s_mov_b32 %0, m0\n\ts_mov_b32 m0, %3\n\ts_nop 0\n\tglobal_load_lds_dwordx4 %1, %2\n\ts_mov_b32 m0, %0" : "=&s"(keep) : "v"(voff), "s"(sbase), "s"(lds_dst) : "memory"); }
__device__ __forceinline__ v8i lds32(lds_cptr p, int second) { const u32x4 a = *(const __attribute__((address_space(3))) u32x4*)p, b = *(const __attribute__((address_space(3))) u32x4*)(p + second);
    return (v8i){(int)a.x, (int)a.y, (int)a.z, (int)a.w, (int)b.x, (int)b.y, (int)b.z, (int)b.w}; }
__device__ __forceinline__ float rowmax32(const f32x16& p0, const f32x16& p1) {
    float pmax = p0[0];
#pragma unroll
    for (int r = 1; r < 16; ++r) pmax = fmaxf(pmax, p0[r]);
#pragma unroll
    for (int r = 0; r < 16; ++r) pmax = fmaxf(pmax, p1[r]);
    auto rr = __builtin_amdgcn_permlane32_swap(__float_as_uint(pmax), __float_as_uint(pmax), false, false); return fmaxf(__uint_as_float(rr[0]), __uint_as_float(rr[1]));
}
__device__ __forceinline__ void mask_tile(f32x16& p0, f32x16& p1, int kidx0, int hi, int lo_k, int qidx) {
    const float NEG = -__builtin_inff();
#pragma unroll
    for (int r = 0; r < 16; ++r) { const int kx = kidx0 + crow(r, hi);
        if (kx < lo_k || kx > qidx) p0[r] = NEG;
        if (kx + 32 < lo_k || kx + 32 > qidx) p1[r] = NEG; }
}
#define pk2_bf8(a, b, old, hiword) __builtin_amdgcn_cvt_pk_bf8_f32((a), (b), (old), (hiword))

__device__ __forceinline__ void attn_unit(int h, int qb, const unsigned char* Q8, const unsigned char* K8, const unsigned char* Vt8, bf16* Ob, char* shm, int lane_in, int wid) {
    const int lane = opq(lane_in), r32 = lane & 31, hi = lane >> 5;
    const unsigned lds0 = (unsigned)(uintptr_t)shm;
    const lds_cptr shm3 = (lds_cptr)shm;
    LAS float* wsf = (LAS float*)(shm + L_WS) + wid * 64;
    const unsigned char* Kh = K8 + (size_t)h * KROWS * DQK; const unsigned char* Vh = Vt8 + (size_t)h * NKT * 128 * 64;
    const unsigned kvo = (unsigned)lane * 16u, vvo = (unsigned)lane * 16u;
    const bool k1 = wid < 4;
    const int jv = k1 ? wid + 4 : wid - 4;
    const unsigned gk0 = 1024u * wid, dk0 = L_K + 1024u * wid, gk1 = 1024u * (8 + wid), dk1 = L_K + 1024u * (8 + wid);
    const unsigned gv = (unsigned)(2048 * (jv >> 1) + 1024 * (jv & 1)), dv = (unsigned)(L_V + 2048 * (jv >> 1) + 1024 * (jv & 1));
#define A8_KB(t) ((const char*)Kh + (size_t)(t) * (64 * DQK))
#define A8_VB(t) ((const char*)Vh + (size_t)(t) * (128 * 64))
#define A8_DMA_K0(t, koff) glds16s(A8_KB(t) + gk0, kvo, (unsigned)__builtin_amdgcn_readfirstlane(lds0 + dk0 + (koff)))
#define A8_DMA_K1(t, koff) do { if (k1) glds16s(A8_KB(t) + gk1, kvo, (unsigned)__builtin_amdgcn_readfirstlane(lds0 + dk1 + (koff))); } while (0)
#define A8_DMA_V(t, voff) glds16s(A8_VB(t) + gv, vvo, (unsigned)__builtin_amdgcn_readfirstlane(lds0 + dv + (voff)))
    const lds_cptr kp0 = shm3 + L_K + hi * 2048 + r32 * 16;
    const lds_cptr vp0 = shm3 + L_V + hi * 4096 + r32 * 16;
    const int NT = 4 * qb + 5;
    const int qidx = KPAD + NMETA + qb * 256 + wid * 32 + r32;
    A8_DMA_K0(0, 0); A8_DMA_K1(0, 0); A8_DMA_V(0, 0); A8_DMA_K0(1, KT); A8_DMA_K1(1, KT);
    v8i qr[3];
    { const unsigned char* Qw = Q8 + ((size_t)h * SEQ + qb * 256 + wid * 32) * DQK + hi * 1024 + r32 * 32;
#pragma unroll
      for (int s = 0; s < 3; ++s) qr[s] = ld32(Qw + 2048 * s); }
    float l_reg = 0.f; f32x16 o[4];
#pragma unroll
    for (int d0 = 0; d0 < 4; ++d0)
#pragma unroll
        for (int r = 0; r < 16; ++r) o[d0][r] = 0.f;
    f32x16 pA0, pA1, pB0, pB1, negm;
#pragma unroll
    for (int r = 0; r < 16; ++r) negm[r] = 0.f;
    int vs_prev = 0, vs_cur = 0, vs_next = VT, ks_cur = 0, ks_nxt = KT, ks_n2 = 2 * KT;
#define A8_ROT() do { vs_prev = vs_cur; vs_cur = vs_next; vs_next = (vs_next == 3 * VT) ? 0 : vs_next + VT; \
        ks_cur = ks_nxt; ks_nxt = ks_n2; ks_n2 = (ks_n2 == 2 * KT) ? 0 : ks_n2 + KT; } while (0)
#define A8_KFRAG(i, kb_) lds32((kb_) + ((i) >> 1) * 4096 + ((i) & 1) * 512, 1024)
#define A8_VFRAG(d, vb_) lds32((vb_) + (d) * 512, 2048)
#define A8_MIDBAR(t) do { if ((t) + 2 < NT) { if (k1) { ATT_WAIT_BAR(3); } else { ATT_WAIT_BAR(2); } } else if ((t) + 1 < NT) { ATT_WAIT_BAR(1); } else { ATT_WAIT_BAR(0); } } while (0)
    ATT_WAIT_BAR(0);
    A8_DMA_K0(2, 2 * KT); A8_DMA_K1(2, 2 * KT); A8_DMA_V(1, VT);
#pragma unroll
    for (int s = 0; s < 3; ++s) { pA0 = MFMA_F8(lds32(kp0 + s * 4096, 1024), qr[s], s ? pA0 : negm, 0); pA1 = MFMA_F8(lds32(kp0 + s * 4096 + 512, 1024), qr[s], s ? pA1 : negm, 0); }
    mask_tile(pA0, pA1, 0, hi, KPAD, qidx);
    { const float m0 = rowmax32(pA0, pA1) - BIAS8;
#pragma unroll
      for (int r = 0; r < 16; ++r) { negm[r] = -m0; pA0[r] -= m0; pA1[r] -= m0; } }
#pragma unroll
    for (int r = 0; r < 16; ++r) pA0[r] = __builtin_amdgcn_exp2f(pA0[r]);
    A8_MIDBAR(0);
    A8_ROT();
    v8i kf[3], vf[3], pp = {0, 0, 0, 0, 0, 0, 0, 0};
    kf[0] = A8_KFRAG(0, kp0 + ks_cur); kf[1] = A8_KFRAG(1, kp0 + ks_cur);
#define A8_STEP(PX0, PX1, PY0, PY1, t) do { \
        float ps_ = 0.f; const lds_cptr kb_ = kp0 + ks_cur; const lds_cptr vb_ = vp0 + vs_prev; \
        _Pragma("unroll") for (int i = 0; i < 6; ++i) { \
            if (i < 4) kf[(i + 2) % 3] = A8_KFRAG(i + 2, kb_); else vf[i - 4] = A8_VFRAG(i - 4, vb_); \
            if (i == 0 && (t) + 2 < NT) A8_DMA_K0((t) + 2, ks_n2); \
            if (i == 1 && (t) + 2 < NT) A8_DMA_K1((t) + 2, ks_n2); \
            if (i == 2 && (t) + 1 < NT) A8_DMA_V((t) + 1, vs_next); \
            ATT_SBAR(); \
            if ((i & 1) == 0) PX0 = MFMA_F8(kf[i % 3], qr[i >> 1], i ? PX0 : negm, 0); else PX1 = MFMA_F8(kf[i % 3], qr[i >> 1], (i >> 1) ? PX1 : negm, 0); \
            _Pragma("unroll") for (int r = (16 * i) / 6; r < (16 * (i + 1)) / 6; ++r) { PY1[r] = __builtin_amdgcn_exp2f(PY1[r]); ps_ += PY0[r]; ps_ += PY1[r]; } \
            if (i >= 1 && i <= 4) { const int w_ = i - 1; int x_ = pk2_bf8(PY0[4 * w_], PY0[4 * w_ + 1], pp[w_], false); pp[w_] = pk2_bf8(PY0[4 * w_ + 2], PY0[4 * w_ + 3], x_, true); } \
            if (i == 3) { int x_ = pk2_bf8(PY1[0], PY1[1], pp[4], false); pp[4] = pk2_bf8(PY1[2], PY1[3], x_, true); } \
            if (i == 4) { int x_ = pk2_bf8(PY1[4], PY1[5], pp[5], false); pp[5] = pk2_bf8(PY1[6], PY1[7], x_, true); } \
            if (i == 5) { int x_ = pk2_bf8(PY1[8], PY1[9], pp[6], false); pp[6] = pk2_bf8(PY1[10], PY1[11], x_, true); int y_ = pk2_bf8(PY1[12], PY1[13], pp[7], false); pp[7] = pk2_bf8(PY1[14], PY1[15], y_, true); } \
            ATT_SBAR(); } \
        asm volatile("" : "+v"(pp));                                      \
        l_reg += ps_;                                                     \
        vf[2] = A8_VFRAG(2, vb_); \
        if ((t) >= NT - 4) mask_tile(PX0, PX1, 64 * (t), hi, 0, qidx); \
        A8_MIDBAR(t); \
        float ra_, rb_; \
        _Pragma("unroll") for (int d_ = 0; d_ < 4; ++d_) { \
            o[d_] = MFMA_F8(pp, vf[d_ % 3], o[d_], 1); \
            if (d_ == 0) { ATT_SBAR(); vf[0] = A8_VFRAG(3, vb_); } \
            if (d_ == 2 && (t) + 1 < NT) { ATT_SBAR(); kf[0] = A8_KFRAG(0, kp0 + ks_nxt); kf[1] = A8_KFRAG(1, kp0 + ks_nxt); } \
              \
            if (d_ == 0) { ra_ = fmaxf(fmaxf(PX0[0], PX0[1]), PX0[2]); rb_ = fmaxf(fmaxf(PX1[0], PX1[1]), PX1[2]); \
                _Pragma("unroll") for (int r = 3; r < 15; r += 2) { ra_ = fmaxf(fmaxf(ra_, PX0[r]), PX0[r + 1]); rb_ = fmaxf(fmaxf(rb_, PX1[r]), PX1[r + 1]); } \
                ra_ = fmaxf(fmaxf(ra_, PX0[15]), fmaxf(rb_, PX1[15])); } \
            _Pragma("unroll") for (int r = 4 * d_; r < 4 * d_ + 4; ++r) PX0[r] = __builtin_amdgcn_exp2f(PX0[r]); \
            ATT_SBAR(); } \
        { auto rr = __builtin_amdgcn_permlane32_swap(__float_as_uint(ra_), __float_as_uint(ra_), false, false); ra_ = fmaxf(__uint_as_float(rr[0]), __uint_as_float(rr[1])); } \
        if (__builtin_expect(__any(ra_ > BIAS8 + THR8), 0)) {        \
            const float dl_ = (ra_ > BIAS8 + THR8) ? ra_ - BIAS8 : 0.f, al_ = __builtin_amdgcn_exp2f(-dl_); \
            _Pragma("unroll") for (int r = 0; r < 16; ++r) { negm[r] -= dl_; PX0[r] *= al_; PX1[r] -= dl_; } \
            l_reg *= al_; if (hi == 0) wsf[r32] = al_; asm volatile("s_waitcnt lgkmcnt(0)" ::: "memory"); \
            _Pragma("unroll") for (int r = 0; r < 16; ++r) { const float f_ = wsf[crow(r, hi)]; _Pragma("unroll") for (int d2 = 0; d2 < 4; ++d2) o[d2][r] *= f_; } } \
        } while (0)
    for (int t = 1; t + 1 < NT; t += 2) {
        A8_STEP(pB0, pB1, pA0, pA1, t); A8_ROT();
        A8_STEP(pA0, pA1, pB0, pB1, t + 1); A8_ROT();
    }
    { float ps_ = 0.f;
#pragma unroll
      for (int r = 0; r < 16; ++r) { pA1[r] = __builtin_amdgcn_exp2f(pA1[r]); ps_ += pA0[r]; ps_ += pA1[r]; }
      l_reg += ps_;
      { auto rr = __builtin_amdgcn_permlane32_swap(__float_as_uint(l_reg), __float_as_uint(l_reg), false, false); l_reg = __uint_as_float(rr[0]) + __uint_as_float(rr[1]); }
#pragma unroll
      for (int w = 0; w < 4; ++w) { int x = pk2_bf8(pA0[4 * w], pA0[4 * w + 1], pp[w], false); pp[w] = pk2_bf8(pA0[4 * w + 2], pA0[4 * w + 3], x, true); int y = pk2_bf8(pA1[4 * w], pA1[4 * w + 1], pp[4 + w], false); pp[4 + w] = pk2_bf8(pA1[4 * w + 2], pA1[4 * w + 3], y, true); }
      const lds_cptr vb_ = vp0 + vs_prev;
#pragma unroll
      for (int d0 = 0; d0 < 4; ++d0) o[d0] = MFMA_F8(pp, A8_VFRAG(d0, vb_), o[d0], 1); }
    if (hi == 0) wsf[32 + r32] = l_reg;
    asm volatile("s_waitcnt lgkmcnt(0)" ::: "memory");
    { const int l2 = opq(lane), r2 = l2 & 31, h2 = l2 >> 5;
      LAS unsigned char* stg = (LAS unsigned char*)(shm + L_OST) + wid * 4096;
      unsigned char* Ow = (unsigned char*)Ob + (size_t)(qb * 256 + wid * 32) * D + h * DV;
#pragma unroll
      for (int r = 0; r < 16; ++r) { const int orow = crow(r, h2); const float li = __builtin_amdgcn_rcpf(wsf[32 + orow]) * O8SCALE;
#pragma unroll
          for (int d0 = 0; d0 < 4; ++d0) { const float v = o[d0][r] * li; stg[orow * 128 + d0 * 32 + r2] = (unsigned char)(__builtin_amdgcn_cvt_pk_fp8_f32(v, v, 0, false) & 0xff); } }
      asm volatile("s_waitcnt lgkmcnt(0)" ::: "memory");
#pragma unroll
      for (int i = 0; i < 4; ++i) { const int row = i * 8 + (l2 >> 3), ch = l2 & 7; const u32x4 v = *(const LAS u32x4*)(stg + row * 128 + ch * 16); *(u32x4*)(Ow + (size_t)row * D + ch * 16) = v; }
      asm volatile("s_waitcnt lgkmcnt(0)" ::: "memory"); }
    asm volatile("s_waitcnt lgkmcnt(0)\n\ts_barrier" ::: "memory");
#undef A8_KB
#undef A8_VB
#undef A8_DMA_K0
#undef A8_DMA_K1
#undef A8_DMA_V
#undef A8_ROT
#undef A8_KFRAG
#undef A8_VFRAG
#undef A8_MIDBAR
#undef A8_STEP
#undef pk2_bf8
}
#undef ATT_SBAR
#undef ATT_WAIT_BAR
}

__device__ __forceinline__ void attn8_phase(const Frame& F) {
    const int lane = (opq(F.tid) & 63);
    for (int it = blockIdx.x; it < 256; it += gridDim.x) {
        const int h = it & 7, x = it >> 3;
#pragma unroll 1
        for (int pass = 0; pass < 2; ++pass) att8::attn_unit(h, pass ? x : 63 - x, F_Q8, F_K8, F_VT8, F_OB, (char*)F.lds, lane, F.wave);
    }
}

template <class Epi>
__device__ __forceinline__ void meta_gemm(const Frame& F, const bf16* A, int lda, const bf16* Bt, int N, int K, const Epi& E) {
    const int lane = (opq(F.tid) & 63), fr = lane & 15, fq = lane >> 4, nun = (N / 256) * 4, kw = K / NWAVES;
    LAS f32x4* red = (LAS f32x4*)F.lds;
    for (int u = blockIdx.x; u < nun; u += gridDim.x) {
        const int g = u & 3, pn = u >> 2;
        const bf16* arow[1] = {A + (size_t)fr * lda + F.wave * kw};
        f32x4 acc[1][2][2];
        wave_mma<1>(arow, Bt + (size_t)(pn * 256 + g * 32) * K + F.wave * kw, kw, lane, acc, K);
        __syncthreads();
#pragma unroll
        for (int j = 0; j < 4; ++j) red[(F.wave * 4 + j) * 64 + lane] = acc[0][j >> 1][j & 1];
        __syncthreads();
        if (F.wave == 0) { f32x4 s[4];
#pragma unroll
            for (int j = 0; j < 4; ++j) { s[j] = red[j * 64 + lane];
#pragma unroll
                for (int w = 1; w < NWAVES; ++w) s[j] = s[j] + red[(w * 4 + j) * 64 + lane]; }
            E.row(fr, pn, g, fq, s[0], s[1], s[2], s[3], true); }
    }
    __syncthreads();
}
__device__ __forceinline__ void meta_kvq(const Frame& F) {
    if ((int)blockIdx.x != (int)gridDim.x - 1) return;
    const int lane = (opq(F.tid) & 63), fr = lane & 15, fq = lane >> 4, kw = D / NWAVES;
    LAS f32x4* red = (LAS f32x4*)F.lds; LAS float* rs = (LAS float*)(F.lds + 32768);
    const bf16* arow[1] = {F_H2 + (size_t)fr * D + F.wave * kw};
    const float s = F_STAT[ST_RSTD2 + fr];
    f32x4 part[5][1][2][2];
#pragma unroll
    for (int u = 0; u < 5; ++u) wave_mma<1>(arow, F_WKVQ + (size_t)(u < 4 ? u * 32 : 512 + 96) * D + F.wave * kw, kw, lane, part[u], D);
    f32x4 mine[4];
#pragma unroll
    for (int u = 0; u < 5; ++u) {
        __syncthreads();
#pragma unroll
        for (int j = 0; j < 4; ++j) red[(F.wave * 4 + j) * 64 + lane] = part[u][0][j >> 1][j & 1];
        __syncthreads();
        if (F.wave == u) {
#pragma unroll
            for (int j = 0; j < 4; ++j) { f32x4 t = red[j * 64 + lane];
#pragma unroll
                for (int w = 1; w < NWAVES; ++w) t = t + red[(w * 4 + j) * 64 + lane];
                mine[j] = t * s; } }
    }
    if (F.wave < 4) { float ss = sumsq8(mine[0], mine[1]) + sumsq8(mine[2], mine[3]); ss += __shfl_xor(ss, 16); ss += __shfl_xor(ss, 32); if (fq == 0) rs[F.wave * 16 + fr] = ss; }
    __syncthreads();
    if (F.wave < 4) { const float tot = (rs[fr] + rs[16 + fr]) + (rs[32 + fr] + rs[48 + fr]); const float rn = 1.f / sqrtf(tot * (1.f / KVRANK) + EPS); const int c = 32 * F.wave + 8 * fq;
        st8(F_CKV + (size_t)fr * KVRANK + c, mine[0] * rn, mine[1] * rn); st8(F_CKV + (size_t)fr * KVRANK + 128 + c, mine[2] * rn, mine[3] * rn); }
    else if (F.wave == 4) { f32x4 o1a, o1b, o2a, o2b; rope8(F_ROPE + ((size_t)fr * 32 + 8 * fq) * 2, mine[0], mine[1], mine[2], mine[3], o1a, o1b, o2a, o2b); krope_store8(F_K8, fr, 8 * fq, o1a, o1b, o2a, o2b); }
    __syncthreads();
}

template <bool ALIGN, class Fn, bool F8 = false>
__device__ __forceinline__ void dense_gemm(const Frame& F, const void* A_main, int N, int K, const void* Bt, const Fn& fn, int M = SEQ, int prow0 = NMETA, int nwg = 0) {
    if (nwg > 0 && (int)blockIdx.x >= nwg) return;
    const pg8::Gemm g{(const bf16*)A_main, (const bf16*)Bt, M, N, F8 ? K / 2 : K}; pg8::StaticOrder S; S.init(M, N, nwg > 0 ? nwg : (int)gridDim.x, (int)blockIdx.x);
    const EpiRows<Fn> E{fn, prow0};
    pg8::gemm_phase<EpiRows<Fn>, pg8::StaticOrder, ALIGN, true, F8>(F.lds, g, S, E);
}

__global__ void __launch_bounds__(NTHREADS, 2) yoco_fwd(Params P) {
    extern __shared__ __attribute__((aligned(16))) unsigned char lds_raw[];
    Frame F;
    F.lds = (LAS unsigned char*)lds_raw;
    F.tid = threadIdx.x; F.wave = __builtin_amdgcn_readfirstlane(F.tid >> 6);
    F.gw = blockIdx.x * NWAVES + F.wave; F.ngw = gridDim.x * NWAVES;
    F.ws = P.ws; F.P = &P;

    for (int u = F.tid; u < (LDS_BYTES - MISC_OFF) / 4; u += NTHREADS) ((LAS unsigned*)(F.lds + MISC_OFF))[u] = 0u;
    __syncthreads();
    XcdBarrier bar = xcd_barrier_post(F_CTL + CW_BAR, (volatile LAS unsigned*)(F.lds + MISC_OFF) + 8);
#define GRID_BAR() xcd_barrier(bar)

#ifdef ONLY_PH
#define PH(k) ((k) == ONLY_PH)
#else
#define PH(k) true
#endif
#ifdef REPEAT_MASK
#define NREP(k) ((((REPEAT_MASK) >> (k)) & 1) ? 2 : 1)
#else
#define NREP(k) 1
#endif
#ifdef REPEAT_MASK
#define PH_BEGIN(k) _Pragma("unroll") for (int rep_ = 0; rep_ < NREP(k); ++rep_) {
#else
#define PH_BEGIN(k) {
#endif
#define PH_END() GRID_BAR(); }
    PH_BEGIN(0)
    if (PH(0)) p0_prologue(F);
    PH_END()
    PH_BEGIN(1)
    if (PH(1)) { const EpiIn E{F_BB, F_ZB, F_STAT + ST_RSTD0}; if (gridDim.x >= 256) { dense_gemm<true>(F, F_H0B + (size_t)NMETA * D, 3072, 1024, F_WIN, E, SEQ, NMETA, 192);
            if ((int)blockIdx.x >= 192) { const int lane = (opq(F.tid) & 63), nfree = (int)gridDim.x - 192, rank = (int)blockIdx.x - 192;
                for (int it = rank * NWAVES + F.wave; it < L0_P1 * IT_EXP; it += nfree * NWAVES) expert_item(F, L0_PRO * IT_EXP + it, nullptr, lane); } }
        else dense_gemm<true>(F, F_H0B + (size_t)NMETA * D, 3072, 1024, F_WIN, E);
        meta_gemm(F, F_H0B, D, F_WIN, 3072, 1024, E); }
    PH_END()
    PH_BEGIN(2)
    if (PH(2)) conv_phase(F);
    PH_END()
    PH_BEGIN(3)
    if (PH(3)) { const EpiOut E{F_H13, F_H0B, F_H8}; dense_gemm<true>(F, F_A2 + (size_t)NMETA * D, 1024, 1024, F_WOUT, E); meta_gemm(F, F_A2, D, F_WOUT, 1024, 1024, E); }
    PH_END()
#if defined(PROBE_ROUTER) && PROBE_ROUTER == 4
    router_phase(F, F_H13, F_WR, F_STAT + ST_RSTD1, F_CTL + CW_CNT + 128, 0, (L0_PRO + L0_P1) * IT_EXP, (NE - L0_PRO - L0_P1) * IT_EXP); GRID_BAR();
#endif
    if (PH(4)) router_phase(F, F_H13, F_WR, F_STAT + ST_RSTD1, F_CTL + CW_CNT, 0, (L0_PRO + L0_P1) * IT_EXP, (NE - L0_PRO - L0_P1) * IT_EXP);
    GRID_BAR();
    moe_tables(F, F_CTL + CW_CNT);
    PH_BEGIN(5)
    if (PH(5)) moe_gu_fast(F, F_H13, F_STAT + ST_RSTD1, 0);
    PH_END()
    PH_BEGIN(6)
    if (PH(6)) moe_down_fast(F, 0);
    PH_END()
    PH_BEGIN(7)
    if (PH(7)) combine_phase<false>(F, F_H13, F_H2, F_STAT + ST_RSTD2, 0);
    PH_END()
    PH_BEGIN(8)
    if (PH(8)) { const int gt = F.gw * 64 + (opq(F.tid) & 63), ngt = F.ngw * 64;
      for (int idx = gt; idx < NH * KPAD * (DQK / 16); idx += ngt) { const int h = idx / (KPAD * (DQK / 16)), rem = idx % (KPAD * (DQK / 16)); *(u32x4*)(F_K8 + k8_off(h, rem / (DQK / 16), 16 * (rem % (DQK / 16)))) = (u32x4){0u, 0u, 0u, 0u}; }
      for (int idx = gt; idx < NH * 128 * 4; idx += ngt) { const int h = idx / 512, rem = idx % 512; *(u32x4*)(F_VT8 + (size_t)h * NKT * 128 * 64 + rem * 16) = (u32x4){0u, 0u, 0u, 0u}; }
      const EpiKvqFused E{F_CKV, F_CQ, F_K8, F_STAT + ST_RSTD2, F_STAT + ST_SSCQ, F_ROPE};
      const pg8::Gemm g{F_H2 + (size_t)NMETA * D, F_WKVQ, SEQ, 768, 1024}; pg8::StaticOrder S; S.init(SEQ, 768, (int)gridDim.x, (int)blockIdx.x);
      pg8::gemm_phase<EpiKvqFused, pg8::StaticOrder, false, true>(F.lds, g, S, E);
      meta_kvq(F);
      { const int G = (int)gridDim.x, first = 192; int nfree = G - 1 - first, rank = (int)blockIdx.x - first;
        if (nfree <= 0) { nfree = G; rank = (int)blockIdx.x; }
        if (rank >= 0 && rank < nfree) { const int lane = (opq(F.tid) & 63);
            for (int it = rank * NWAVES + F.wave; it < L1_P8 * IT_EXP; it += nfree * NWAVES) expert_item(F, (NE + L1_P5) * IT_EXP + it, nullptr, lane); } } }
    PH_END()
    PH_BEGIN(9)
    if (PH(9)) { const EpiKnope8 E{F_K8}; dense_gemm<false>(F, F_CKV + (size_t)NMETA * KVRANK, 1024, 256, F_WK, E); meta_gemm(F, F_CKV, KVRANK, F_WK, 1024, 256, E); }
    if (PH(91)) { const EpiVt8 E{F_VT8}; dense_gemm<false>(F, F_WV, SEQ, 256, F_CKV + (size_t)NMETA * KVRANK, E, 1024, 0); const EpiVt8Meta Em{F_VT8}; meta_gemm(F, F_CKV, KVRANK, F_WV, 1024, 256, Em); }
    if (PH(90)) { const EpiQUp8 E{F_Q8, F_STAT + ST_SSCQ, F_ROPE}; dense_gemm<true>(F, F_CQ + (size_t)NMETA * QRANK, 1536, 384, F_WUQ, E); }
    PH_END()
    PH_BEGIN(10)
    if (PH(10)) attn8_phase(F);
    PH_END()
    PH_BEGIN(11)
    if (PH(11)) { const EpiRes E{F_H13, F_H2, F_H8, 1.f / (WO8SCALE * O8SCALE), 0}; dense_gemm<true, EpiRes, true>(F, F_O8, 1024, 1024, F_WO, E);
        { const int lane = (opq(F.tid) & 63), e0 = L1_P5 + L1_P8 + L1_P12;
          for (int it = F.gw; it < (NE - e0) * IT_EXP; it += F.ngw) expert_item(F, (NE + e0) * IT_EXP + it, nullptr, lane); } }
    PH_END()
#if defined(PROBE_ROUTER) && PROBE_ROUTER == 12
    router_phase(F, F_H13, F_WR + 96 * 1024, F_STAT + ST_RSTD3, F_CTL + CW_CNT + 192, NMETA, (NE + L1_P5 + L1_P8) * IT_EXP, L1_P12 * IT_EXP); GRID_BAR();
#endif
    if (PH(12)) router_phase(F, F_H13, F_WR + 96 * 1024, F_STAT + ST_RSTD3, F_CTL + CW_CNT + 64, NMETA, (NE + L1_P5 + L1_P8) * IT_EXP, L1_P12 * IT_EXP);
    GRID_BAR();
    moe_tables(F, F_CTL + CW_CNT + 64);
    PH_BEGIN(13)
    if (PH(13)) moe_gu_fast(F, F_H13, F_STAT + ST_RSTD3, 1);
    PH_END()
    PH_BEGIN(14)
    if (PH(14)) moe_down_fast(F, 1);
    PH_END()
    PH_BEGIN(15) if (PH(15)) combine_phase<true>(F, F_H13, nullptr, nullptr, NMETA); }
}

extern "C" void kernel_launch(void* const* d_in, const int* in_sizes, int n_in, void* d_out, int out_size, void* d_ws, size_t ws_size, hipStream_t stream) {
    static int grid = 0;
    if (grid == 0) {
        if (n_in != 21 || out_size != SEQ * D || ws_size < WS_END) { fprintf(stderr, "kernel_launch: unexpected shapes (n_in %d out %d ws %zu, need %zu)\n", n_in, out_size, ws_size, (size_t)WS_END); grid = -1; return; }
        int dev = 0, cus = 0, per_cu = 0;
        if (hipGetDevice(&dev) != hipSuccess || hipDeviceGetAttribute(&cus, hipDeviceAttributeMultiprocessorCount, dev) != hipSuccess) { grid = -1; return; }
        if (hipFuncSetAttribute((const void*)yoco_fwd, hipFuncAttributeMaxDynamicSharedMemorySize, LDS_BYTES) != hipSuccess) { fprintf(stderr, "kernel_launch: hipFuncSetAttribute failed\n"); grid = -1; return; }
        if (hipOccupancyMaxActiveBlocksPerMultiprocessor(&per_cu, (const void*)yoco_fwd, NTHREADS, LDS_BYTES) != hipSuccess || per_cu < 1) { fprintf(stderr, "kernel_launch: occupancy query says %d\n", per_cu); (void)hipGetLastError(); grid = -1; return; }
        grid = cus;
    }
    if (grid < 0) return;
    if (hipMemsetAsync((char*)d_ws + WS_CTL, 0, CTL_ZERO_BYTES, stream) != hipSuccess) return;
    Params p{};
    for (int i = 0; i < 21; ++i) p.in[i] = (const float*)d_in[i];
    p.out = (float*)d_out; p.ws = (unsigned char*)d_ws; p.pad0 = 0; p.pad1 = 0;
    hipLaunchKernelGGL(yoco_fwd, dim3(grid), dim3(NTHREADS), LDS_BYTES, stream, p);
}
```

```cpp
#include <hip/hip_runtime.h>
#include <cstdio>
#include <cstdint>

#define GAS __attribute__((address_space(1)))
#define LAS __attribute__((address_space(3)))
typedef unsigned short bf16;
typedef short bf16x8 __attribute__((ext_vector_type(8)));
typedef float f32x4 __attribute__((ext_vector_type(4)));
typedef float f32x16 __attribute__((ext_vector_type(16)));
typedef unsigned u32x4 __attribute__((ext_vector_type(4)));
typedef unsigned u32x2 __attribute__((ext_vector_type(2)));

constexpr int D = 1024, SEQ = 16384, NMETA = 16, T = SEQ + NMETA, TP = 16640;
constexpr int NH = 8, DQK = 192, DV = 128, QRANK = 384, KVRANK = 256;
constexpr int NE = 64, DE = 256;
constexpr int KROWS = 16448, KPAD = 48;
constexpr int CAP = 16400;
constexpr float EPS = 1e-6f;
constexpr float QSCALE = 0.07216878364870322f * 1.4426950408889634f;
constexpr int NWAVES = 8, NTHREADS = 512;

constexpr size_t MiB = 1u << 20;
constexpr size_t WS_CTL = 0, CTL_ZERO_BYTES = 1 * MiB;
constexpr size_t WS_ROPE = 2 * MiB;
constexpr size_t WS_STAT = 7 * MiB;
constexpr size_t WS_TSLOT = 9 * MiB;
constexpr size_t WS_TOK = 10 * MiB;
constexpr size_t WS_WOF = 15 * MiB;
constexpr size_t WS_WIN = 20 * MiB, WS_WOUT = 26 * MiB, WS_WO = 28 * MiB, WS_WKVQ = 30 * MiB, WS_WUKV = 32 * MiB, WS_WUQ = 33 * MiB, WS_WR = 35 * MiB;
constexpr size_t WS_WGU = 36 * MiB;
constexpr size_t WS_WD = 164 * MiB;
constexpr size_t WS_H13 = 228 * MiB, WS_H2 = 261 * MiB, WS_CKV = 294 * MiB, WS_CQ = 303 * MiB;
constexpr size_t WS_ARENA = 316 * MiB;
constexpr size_t AR_K = 0, AR_V = 49 * MiB, AR_Q = 82 * MiB, AR_O = 130 * MiB;
constexpr size_t AR_K8 = 0, AR_VT8 = 26 * MiB, AR_Q8 = 44 * MiB;
constexpr int NKT = 257;
constexpr size_t AR_H0 = 0, AR_B = 33 * MiB, AR_Z = 66 * MiB, AR_A2 = 99 * MiB;
constexpr size_t AR_HH = 0, AR_YS = 24 * MiB;
constexpr size_t WS_H8 = WS_ARENA + 162 * MiB;
constexpr size_t WS_END = WS_H8 + 17 * MiB;
constexpr int ST_RSTD0 = 0, ST_RSTD1 = TP, ST_RSTD2 = 2 * TP, ST_RSTD3 = 3 * TP, ST_SSCKV = 4 * TP, ST_SSCQ = 8 * TP;
constexpr int CW_BAR = 4096, CW_CNT = 8192;

constexpr int LDS_BYTES = 147456;
constexpr int MISC_OFF = 131072;

__device__ const float ROPE_INV[32] = {
    1.000000000e+00f, 7.498942614e-01f, 5.623413324e-01f, 4.216965139e-01f, 3.162277639e-01f, 2.371373773e-01f, 1.778279394e-01f, 1.333521307e-01f,
    1.000000015e-01f, 7.498941571e-02f, 5.623413250e-02f, 4.216965288e-02f, 3.162277490e-02f, 2.371373773e-02f, 1.778279431e-02f, 1.333521493e-02f,
    9.999999776e-03f, 7.498941850e-03f, 5.623413250e-03f, 4.216964822e-03f, 3.162277630e-03f, 2.371373586e-03f, 1.778279431e-03f, 1.333521446e-03f,
    1.000000047e-03f, 7.498942432e-04f, 5.623413017e-04f, 4.216965172e-04f, 3.162277571e-04f, 2.371373703e-04f, 1.778279402e-04f, 1.333521504e-04f};

#define LDS_WAIT() asm volatile("s_waitcnt lgkmcnt(0)" ::: "memory")
#define VM_WAIT() asm volatile("s_waitcnt vmcnt(0)" ::: "memory")
__device__ __forceinline__ unsigned cvtpk(float lo, float hi) { unsigned r; asm("v_cvt_pk_bf16_f32 %0, %1, %2" : "=v"(r) : "v"(lo), "v"(hi)); return r; }
__device__ __forceinline__ u32x4 pack8(f32x4 a, f32x4 b) { u32x4 w; w.x = cvtpk(a[0], a[1]); w.y = cvtpk(a[2], a[3]); w.z = cvtpk(b[0], b[1]); w.w = cvtpk(b[2], b[3]); return w; }
__device__ __forceinline__ float bflo(unsigned w) { return __builtin_bit_cast(float, w << 16); }
__device__ __forceinline__ float bfhi(unsigned w) { return __builtin_bit_cast(float, w & 0xffff0000u); }
__device__ __forceinline__ void unpack8(u32x4 w, float (&f)[8]) { f[0] = bflo(w.x); f[1] = bfhi(w.x); f[2] = bflo(w.y); f[3] = bfhi(w.y); f[4] = bflo(w.z); f[5] = bfhi(w.z); f[6] = bflo(w.w); f[7] = bfhi(w.w); }
__device__ __forceinline__ float wave_sum(float v) {
#define WS_DPP(ctrl, rmask, bmask) v += __builtin_bit_cast(float, __builtin_amdgcn_update_dpp(0, __builtin_bit_cast(int, v), (ctrl), (rmask), (bmask), false))
    WS_DPP(0x111, 0xf, 0xf);
    WS_DPP(0x112, 0xf, 0xf);
    WS_DPP(0x114, 0xf, 0xf);
    WS_DPP(0x118, 0xf, 0xf);
    WS_DPP(0x142, 0xa, 0xf);
    WS_DPP(0x143, 0xc, 0xf);
#undef WS_DPP
    return __builtin_bit_cast(float, __builtin_amdgcn_readlane(__builtin_bit_cast(int, v), 63));
}
__device__ __forceinline__ int opq(int v) { asm volatile("" : "+v"(v)); return v; }
__device__ __forceinline__ int crow(int r, int hi) { return (r & 3) + 8 * (r >> 2) + 4 * hi; }

#define XB_TMO      128
#define XB_XCNT(j)  (256  + 64 * (j))
#define XB_XSUB(j)  (1280 + 64 * (j))
#define XB_XGEN(j)  (2304 + 64 * (j))
#define XB_TOP      3328
#define XB_TOPGEN   3392
#define XCD_BAR_WORDS 3456
#define XB_SPIN_CAP (1u << 18)

__device__ __forceinline__ unsigned xb_ld(unsigned* p)              { return __hip_atomic_load(p, __ATOMIC_RELAXED, __HIP_MEMORY_SCOPE_AGENT); }
__device__ __forceinline__ unsigned xb_add(unsigned* p, unsigned v) { return __hip_atomic_fetch_add(p, v, __ATOMIC_RELAXED, __HIP_MEMORY_SCOPE_AGENT); }
__device__ __forceinline__ unsigned xb_xcc_id() { return (unsigned)__builtin_amdgcn_s_getreg((3 << 11) | 20) & 0xFu; }
#define XB_SPIN(cond, bar) do { unsigned _sp = 0; while (cond) { __builtin_amdgcn_s_sleep(1); \
    if ((++_sp & 255u) == 0u) { if (xb_ld(&(bar)[XB_TMO])) break; if (_sp > XB_SPIN_CAP) { atomicAdd(&(bar)[XB_TMO], 1u); break; } } } } while (0)

struct XcdBarrier {
    unsigned* bar; unsigned x;
    volatile LAS unsigned* st;
};
__device__ __forceinline__ XcdBarrier xcd_barrier_post(unsigned* bar, volatile LAS unsigned* st) {
    XcdBarrier b; b.bar = bar; b.x = xb_xcc_id(); b.st = st;
    if (threadIdx.x == 0) (void)xb_add(&bar[XB_XCNT(b.x)], 1u);
    return b;
}
__device__ __forceinline__ void xcd_barrier_complete(unsigned* bar, unsigned x, unsigned& nloc, unsigned& nx) {
    const unsigned G = gridDim.x * gridDim.y * gridDim.z;
    unsigned sum, cnt, mine, sp = 0u;
    for (;;) {
        sum = 0u; cnt = 0u; mine = 0u;
#pragma unroll
        for (unsigned j = 0; j < 16; ++j) { const unsigned c = xb_ld(&bar[XB_XCNT(j)]); sum += c; cnt += (c > 0u) ? 1u : 0u; mine = (j == x) ? c : mine; }
        if (sum == G) break;
        __builtin_amdgcn_s_sleep(1);
        if ((++sp & 255u) == 0u) { if (xb_ld(&bar[XB_TMO])) break; if (sp > XB_SPIN_CAP) { atomicAdd(&bar[XB_TMO], 1u); break; } }
    }
    nloc = mine > 0u ? mine : 1u; nx = cnt > 0u ? cnt : 1u;
}
__device__ __forceinline__ void xcd_barrier(const XcdBarrier& b) {
    asm volatile("s_waitcnt vmcnt(0)" ::: "memory");
    __syncthreads();
    if (threadIdx.x == 0) {
        unsigned* bar = b.bar;
        __builtin_amdgcn_s_waitcnt(0);
        unsigned nloc = b.st[0], nx = b.st[1];
        if (nloc == 0u) { xcd_barrier_complete(bar, b.x, nloc, nx); b.st[0] = nloc; b.st[1] = nx; }
        const unsigned old = xb_add(&bar[XB_XSUB(b.x)], 1u);
        const unsigned gen = old / nloc;
        if (old + 1u == (gen + 1u) * nloc) {
            __builtin_amdgcn_fence(__ATOMIC_RELEASE, "agent");
            asm volatile("s_waitcnt vmcnt(0)" ::: "memory");
            const unsigned og = xb_add(&bar[XB_TOP], 1u);
            const unsigned tg = og / nx;
            if (og + 1u == (tg + 1u) * nx) xb_add(&bar[XB_TOPGEN], 1u);
            else XB_SPIN(xb_ld(&bar[XB_TOPGEN]) == tg, bar);
            __builtin_amdgcn_fence(__ATOMIC_ACQUIRE, "agent");
            xb_add(&bar[XB_XGEN(b.x)], 1u);
            asm volatile("s_waitcnt vmcnt(0)" ::: "memory");
        } else {
            XB_SPIN(xb_ld(&bar[XB_XGEN(b.x)]) == gen, bar);
            __builtin_amdgcn_fence(__ATOMIC_ACQUIRE, "workgroup");
            asm volatile("buffer_inv sc0\n\ts_waitcnt vmcnt(0)" ::: "memory");
        }
    }
    __syncthreads();
}


namespace pg8 {
#define PG8_LAS __attribute__((address_space(3)))
typedef unsigned short bf16_t;
typedef short bf16x8 __attribute__((ext_vector_type(8)));
typedef float f32x4 __attribute__((ext_vector_type(4)));
typedef unsigned u32x4 __attribute__((ext_vector_type(4)));
constexpr int BM = 256, BK = 64, HALF = 128, HTB = HALF * BK * 2  , STAGE_BYTES = 8 * HTB, NXCD = 8, WGM = 8;

__host__ __device__ __forceinline__ int lds_byte(int r, int c) { const int st = (r >> 4) * 2 + (c >> 5), rr = r & 15, cc = c & 31, ob = rr * 64 + cc * 2; return st * 1024 + (ob ^ (((ob >> 9) & 1) << 5)); }
__host__ __device__ __forceinline__ void stage_rc(int b, int& R, int& C) { const int st = b / 1024, sb = b % 1024, swz = sb ^ (((sb >> 9) & 1) << 5); R = (st >> 1) * 16 + swz / 64; C = (st & 1) * 32 + (swz % 64) / 2; }
__host__ __device__ __forceinline__ int perm32(int rho) { const int n = rho >> 4, i = rho & 15; return 8 * (i >> 2) + 4 * n + (i & 3); }

__host__ __device__ __forceinline__ int permkv(int rho) { const int n = rho >> 4, i = rho & 15, q = i >> 2; return 4 * (q & 1) + 16 * (q >> 1) + 8 * n + (i & 3); }
template <class T, class = void> struct has_perm2 { static constexpr bool value = false; };
template <class T> struct has_perm2<T, decltype((void)T::PERM2, void())> { static constexpr bool value = T::PERM2; };
struct Unit { int pm, pn; };
struct Gemm { const bf16_t* A; const bf16_t* Bt; int M, N, K; };

struct StaticOrder {
    int nM, nN, nwg, G, c;
    __host__ __device__ void init(int M, int N, int G_, int c_) { nM = M / BM; nN = N / BM; nwg = nM * nN; G = G_; c = c_; }
    __host__ __device__ bool next(int i, Unit& u) const {
        const long L = (long)i * G + c; if (L >= nwg) return false;
        int wgid = (int)L; { const int q = nwg / NXCD, r = nwg % NXCD, xcd = wgid % NXCD, off = wgid / NXCD; wgid = (xcd < r ? xcd * (q + 1) : r * (q + 1) + (xcd - r) * q) + off; }
        const int nig = WGM * nN, gid = wgid / nig, fm = gid * WGM, gsz = (nM - fm) < WGM ? (nM - fm) : WGM;
        u.pm = fm + ((wgid % nig) % gsz); u.pn = (wgid % nig) / gsz; return true;
    }
    __device__ __forceinline__ void a_ready(const Unit&) const {}
    __device__ __forceinline__ void done(const Unit&) const {}
};
typedef int v4i_ __attribute__((ext_vector_type(4)));
typedef int v8i_ __attribute__((ext_vector_type(8)));
__device__ __forceinline__ void mfma8_tied(f32x4& acc, const v8i_& a, const v8i_& b, unsigned sc) {
    asm volatile("v_mfma_scale_f32_16x16x128_f8f6f4 %0, %1, %2, %0, %3, %3 op_sel_hi:[0,0,0]" : "+v"(acc) : "v"(a), "v"(b), "v"(sc)); }
__device__ __forceinline__ v8i_ cat8(bf16x8 a, bf16x8 b) { return __builtin_shufflevector(__builtin_bit_cast(v4i_, a), __builtin_bit_cast(v4i_, b), 0, 1, 2, 3, 4, 5, 6, 7); }
template <class Epi, class Sched, bool ALIGN_EPI = false, bool SP2 = false, bool F8 = false>
__device__ __forceinline__ void gemm_phase(PG8_LAS unsigned char* lds, const Gemm g, const Sched& S, const Epi& E) {
    int tid_ = threadIdx.x; asm volatile("" : "+v"(tid_));
    const int tid = tid_, wid = __builtin_amdgcn_readfirstlane(tid >> 6), lane = tid & 63, wr = wid >> 2, wc = wid & 3, fr = lane & 15, fq = lane >> 4;
    int K_ = g.K; asm volatile("" : "+s"(K_));
    const int K = K_, nt = K / BK;
    unsigned voffA[2], voffB[2];
#pragma unroll
    for (int i = 0; i < 2; ++i) { int R, C; stage_rc(tid * 16 + i * 8192, R, C); const int Rb = Epi::PERM ? ((R & ~31) + (has_perm2<Epi>::value ? permkv(R & 31) : perm32(R & 31))) : R;
        voffA[i] = (unsigned)(R * K + C) * 2u; voffB[i] = (unsigned)(Rb * K + C) * 2u; }
    const size_t kstep = (size_t)(BK * 2);
    const size_t hstep = (size_t)HALF * K * 2;
    const size_t tstep = 2 * hstep;
    const unsigned ldsw = (unsigned)wid * 1024u;
    const int aoff = lds_byte(wr * 64 + fr, fq * 8), boff = lds_byte(wc * 32 + fr, fq * 8);
#define PG8_SA(b, h) (((b) * 2 + (h)) * HTB)
#define PG8_SB(b, h) ((4 + (b) * 2 + (h)) * HTB)
#define PG8_STAGE(bufoff, gbase, voff) do { _Pragma("unroll") for (int _i = 0; _i < 2; ++_i) \
        __builtin_amdgcn_global_load_lds((const unsigned*)((const char*)(gbase) + (voff)[_i]), (PG8_LAS unsigned*)(lds + (bufoff) + ldsw + _i * 8192), 16, 0, 0); } while (0)
#define PG8_LDA(dst, b, h) do { _Pragma("unroll") for (int m = 0; m < 4; ++m) { \
        if constexpr (F8) dst##8[m] = cat8(*(const PG8_LAS bf16x8*)(lds + PG8_SA(b, h) + aoff + m * 2048), *(const PG8_LAS bf16x8*)(lds + PG8_SA(b, h) + aoff + m * 2048 + 1024)); \
        else { _Pragma("unroll") for (int k = 0; k < 2; ++k) dst[m][k] = *(const PG8_LAS bf16x8*)(lds + PG8_SA(b, h) + aoff + m * 2048 + k * 1024); } } } while (0)
#define PG8_LDB(dst, b, h) do { _Pragma("unroll") for (int n = 0; n < 2; ++n) { \
        if constexpr (F8) dst##8[n] = cat8(*(const PG8_LAS bf16x8*)(lds + PG8_SB(b, h) + boff + n * 2048), *(const PG8_LAS bf16x8*)(lds + PG8_SB(b, h) + boff + n * 2048 + 1024)); \
        else { _Pragma("unroll") for (int k = 0; k < 2; ++k) dst[n][k] = *(const PG8_LAS bf16x8*)(lds + PG8_SB(b, h) + boff + n * 2048 + k * 1024); } } } while (0)
#define PG8_MMA(ai, bj, At, Bt) do { __builtin_amdgcn_s_setprio(1); _Pragma("unroll") for (int m = 0; m < 4; ++m) _Pragma("unroll") for (int n = 0; n < 2; ++n) { \
        if constexpr (F8) mfma8_tied(acc[ai][bj][m][n], Bt##8[n], At##8[m], one8); \
        else { _Pragma("unroll") for (int k = 0; k < 2; ++k) acc[ai][bj][m][n] = __builtin_amdgcn_mfma_f32_16x16x32_bf16(Bt[n][k], At[m][k], acc[ai][bj][m][n], 0, 0, 0); } } \
        __builtin_amdgcn_s_setprio(0); } while (0)
#define PG8_WAIT_V(n) asm volatile("s_waitcnt vmcnt(" #n ")" ::: "memory")
#define PG8_WAIT_L(n) asm volatile("s_waitcnt lgkmcnt(" #n ")" ::: "memory")
#define PG8_BAR __builtin_amdgcn_s_barrier()
#define PG8_SCHED __builtin_amdgcn_sched_barrier(0)
    Unit cur, nxt; int ui = 0;
    if (!S.next(0, cur)) return;
    f32x4 acc[2][2][4][2];
#pragma unroll
    for (int a = 0; a < 2; ++a)
#pragma unroll
        for (int b = 0; b < 2; ++b)
#pragma unroll
            for (int m = 0; m < 4; ++m)
#pragma unroll
                for (int n = 0; n < 2; ++n) acc[a][b][m][n] = (f32x4){0.f, 0.f, 0.f, 0.f};
    bf16x8 At[4][2], B0[2][2], B1[2][2]; v8i_ At8[4], B08[2], B18[2];
    unsigned one8 = 0x7f7f7f7fu; asm volatile("" : "+v"(one8));
    const char* cA = (const char*)g.A + (size_t)cur.pm * tstep; const char* cB = (const char*)g.Bt + (size_t)cur.pn * tstep;
    S.a_ready(cur);
    if constexpr (SP2) {
        PG8_STAGE(PG8_SB(0, 0), cB, voffB); PG8_STAGE(PG8_SB(0, 1), cB + hstep, voffB); PG8_STAGE(PG8_SA(0, 0), cA, voffA); PG8_STAGE(PG8_SA(0, 1), cA + hstep, voffA);
        if (wr == 1) PG8_BAR;
        PG8_WAIT_V(2); PG8_BAR;
        PG8_STAGE(PG8_SB(1, 0), cB + kstep, voffB); PG8_STAGE(PG8_SA(1, 0), cA + kstep, voffA); PG8_STAGE(PG8_SB(1, 1), cB + hstep + kstep, voffB);
        PG8_WAIT_V(6); PG8_BAR;
    } else {
        PG8_STAGE(PG8_SB(0, 0), cB, voffB); PG8_STAGE(PG8_SA(0, 0), cA, voffA); PG8_STAGE(PG8_SB(0, 1), cB + hstep, voffB); PG8_STAGE(PG8_SA(0, 1), cA + hstep, voffA);
        if (wr == 1) PG8_BAR;
        PG8_WAIT_V(4); PG8_BAR;
        PG8_STAGE(PG8_SB(1, 0), cB + kstep, voffB); PG8_STAGE(PG8_SA(1, 0), cA + kstep, voffA); PG8_STAGE(PG8_SB(1, 1), cB + hstep + kstep, voffB);
        PG8_WAIT_V(6); PG8_BAR;
    }
    for (;;) {
        const bool has_next = S.next(ui + 1, nxt);
        const char* nA = has_next ? (const char*)g.A + (size_t)nxt.pm * tstep : cA; const char* nB = has_next ? (const char*)g.Bt + (size_t)nxt.pn * tstep : cB;
#pragma unroll 1
        for (int t = 0; t < nt; t += 2) {
            const bool last = (t == nt - 2);
            const char* a1 = cA + (size_t)(t + 1) * kstep;
            const char* a2 = last ? nA : cA + (size_t)(t + 2) * kstep; const char* b2 = last ? nB : cB + (size_t)(t + 2) * kstep;
            const char* a3 = a2 + kstep; const char* b3 = b2 + kstep;
            if (last && has_next) S.a_ready(nxt);
            if constexpr (SP2) {
            PG8_LDB(B0, 0, 0); PG8_LDB(B1, 0, 1); PG8_SCHED; PG8_LDA(At, 0, 0); PG8_STAGE(PG8_SA(1, 1), a1 + hstep, voffA);
            PG8_WAIT_V(8); PG8_WAIT_L(0); PG8_BAR; PG8_MMA(0, 0, At, B0); PG8_MMA(0, 1, At, B1); PG8_BAR; PG8_SCHED;
            PG8_LDA(At, 0, 1); PG8_STAGE(PG8_SB(0, 0), b2, voffB); PG8_STAGE(PG8_SB(0, 1), b2 + hstep, voffB); PG8_STAGE(PG8_SA(0, 0), a2, voffA);
            PG8_WAIT_V(8); PG8_WAIT_L(0); PG8_BAR; PG8_MMA(1, 0, At, B0); PG8_MMA(1, 1, At, B1); PG8_BAR; PG8_SCHED;
            PG8_LDB(B0, 1, 0); PG8_LDB(B1, 1, 1); PG8_SCHED; PG8_LDA(At, 1, 0); PG8_STAGE(PG8_SA(0, 1), a2 + hstep, voffA);
            PG8_WAIT_V(8); PG8_WAIT_L(0); PG8_BAR; PG8_MMA(0, 0, At, B0); PG8_MMA(0, 1, At, B1); PG8_BAR; PG8_SCHED;
            PG8_LDA(At, 1, 1); PG8_STAGE(PG8_SB(1, 0), b3, voffB); PG8_STAGE(PG8_SB(1, 1), b3 + hstep, voffB); PG8_STAGE(PG8_SA(1, 0), a3, voffA);
            PG8_WAIT_V(8); PG8_WAIT_L(0); PG8_BAR; PG8_MMA(1, 0, At, B0); PG8_MMA(1, 1, At, B1); PG8_BAR; PG8_SCHED;
            } else {
            PG8_LDB(B0, 0, 0); PG8_SCHED; PG8_LDA(At, 0, 0); PG8_STAGE(PG8_SA(1, 1), a1 + hstep, voffA);
            PG8_WAIT_L(8); PG8_BAR; PG8_WAIT_L(0); PG8_MMA(0, 0, At, B0); PG8_BAR; PG8_SCHED;
            PG8_LDB(B1, 0, 1); PG8_STAGE(PG8_SB(0, 0), b2, voffB);
            PG8_BAR; PG8_WAIT_L(0); PG8_MMA(0, 1, At, B1); PG8_BAR;
            PG8_LDA(At, 0, 1); PG8_STAGE(PG8_SA(0, 0), a2, voffA);
            PG8_BAR; PG8_WAIT_L(0); PG8_MMA(1, 0, At, B0); PG8_BAR; PG8_SCHED;
            PG8_STAGE(PG8_SB(0, 1), b2 + hstep, voffB);
            PG8_WAIT_V(6); PG8_BAR; PG8_MMA(1, 1, At, B1); PG8_BAR;
            PG8_LDB(B0, 1, 0); PG8_SCHED; PG8_LDA(At, 1, 0); PG8_STAGE(PG8_SA(0, 1), a2 + hstep, voffA);
            PG8_WAIT_L(8); PG8_BAR; PG8_WAIT_L(0); PG8_MMA(0, 0, At, B0); PG8_BAR; PG8_SCHED;
            PG8_LDB(B1, 1, 1); PG8_STAGE(PG8_SB(1, 0), b3, voffB);
            PG8_BAR; PG8_WAIT_L(0); PG8_MMA(0, 1, At, B1); PG8_BAR;
            PG8_LDA(At, 1, 1); PG8_STAGE(PG8_SA(1, 0), a3, voffA);
            PG8_BAR; PG8_WAIT_L(0); PG8_MMA(1, 0, At, B0); PG8_BAR; PG8_SCHED;
            PG8_STAGE(PG8_SB(1, 1), b3 + hstep, voffB);
            PG8_WAIT_V(6); PG8_BAR; PG8_MMA(1, 1, At, B1); PG8_BAR;
            }
        }
        if constexpr (ALIGN_EPI) { if (wr == 0) PG8_BAR; }
        if constexpr (F8) asm volatile("s_nop 15\n\ts_nop 7" ::: "memory");
        if constexpr (!Epi::AFTER_DRAIN) { E(acc, cur, wr, wc, fr, fq); S.done(cur); }
        if (!has_next) break;
#pragma unroll
        for (int a = 0; a < 2; ++a)
#pragma unroll
            for (int b = 0; b < 2; ++b)
#pragma unroll
                for (int m = 0; m < 4; ++m)
#pragma unroll
                    for (int n = 0; n < 2; ++n) acc[a][b][m][n] = (f32x4){0.f, 0.f, 0.f, 0.f};
        cur = nxt; cA = nA; cB = nB; ++ui;
        if constexpr (ALIGN_EPI) { if (wr == 1) PG8_BAR; }
    }
    PG8_WAIT_V(0);
    if constexpr (!ALIGN_EPI) { if (wr == 0) PG8_BAR; }
    PG8_BAR;
    if constexpr (Epi::AFTER_DRAIN) { E.fused(acc, cur, wr, wc, fr, fq, lds, wid, lane); S.done(cur); }
#undef PG8_SA
#undef PG8_SB
#undef PG8_STAGE
#undef PG8_LDA
#undef PG8_LDB
#undef PG8_MMA
#undef PG8_WAIT_V
#undef PG8_WAIT_L
#undef PG8_BAR
#undef PG8_SCHED
}
}

namespace pg8 {
struct MUnit { int pm, pn, slot; const bf16_t* bt; };
template <class Epi, class Sched, bool ALIGN_EPI, bool GATHER, bool F8 = false>
__device__ __forceinline__ void gemm_phase_moe(PG8_LAS unsigned char* lds, const bf16_t* Abase, int Kin, const Sched& S, const Epi& E, const PG8_LAS unsigned* rowoff_tab, int tab_stride) {
    int tid_ = threadIdx.x; asm volatile("" : "+v"(tid_));
    const int tid = tid_, wid = __builtin_amdgcn_readfirstlane(tid >> 6), lane = tid & 63, wr = wid >> 2, wc = wid & 3, fr = lane & 15, fq = lane >> 4;
    int K_ = Kin; asm volatile("" : "+s"(K_));
    const int K = K_, nt = K / BK;
    unsigned voffA[2], voffB[2]; int RA[2]; unsigned CA[2];
#pragma unroll
    for (int i = 0; i < 2; ++i) { int R, C; stage_rc(tid * 16 + i * 8192, R, C); const int Rb = Epi::PERM ? ((R & ~31) + perm32(R & 31)) : R;
        voffA[i] = (unsigned)(R * K + C) * 2u; voffB[i] = (unsigned)(Rb * K + C) * 2u; RA[i] = R; CA[i] = (unsigned)C * 2u; }
    const size_t kstep = (size_t)(BK * 2);
    const size_t hstep = (size_t)HALF * K * 2;
    const size_t tstep = 2 * hstep;
    const unsigned ldsw = (unsigned)wid * 1024u;
    const int aoff = lds_byte(wr * 64 + fr, fq * 8), boff = lds_byte(wc * 32 + fr, fq * 8);
#define PG8_SA(b, h) (((b) * 2 + (h)) * HTB)
#define PG8_SB(b, h) ((4 + (b) * 2 + (h)) * HTB)
#define PG8_STAGE(bufoff, gbase, voff) do { _Pragma("unroll") for (int _i = 0; _i < 2; ++_i) \
        __builtin_amdgcn_global_load_lds((const unsigned*)((const char*)(gbase) + (voff)[_i]), (PG8_LAS unsigned*)(lds + (bufoff) + ldsw + _i * 8192), 16, 0, 0); } while (0)
#define PG8_LDA(dst, b, h) do { _Pragma("unroll") for (int m = 0; m < 4; ++m) { \
        if constexpr (F8) dst##8[m] = cat8(*(const PG8_LAS bf16x8*)(lds + PG8_SA(b, h) + aoff + m * 2048), *(const PG8_LAS bf16x8*)(lds + PG8_SA(b, h) + aoff + m * 2048 + 1024)); \
        else { _Pragma("unroll") for (int k = 0; k < 2; ++k) dst[m][k] = *(const PG8_LAS bf16x8*)(lds + PG8_SA(b, h) + aoff + m * 2048 + k * 1024); } } } while (0)
#define PG8_LDB(dst, b, h) do { _Pragma("unroll") for (int n = 0; n < 2; ++n) { \
        if constexpr (F8) dst##8[n] = cat8(*(const PG8_LAS bf16x8*)(lds + PG8_SB(b, h) + boff + n * 2048), *(const PG8_LAS bf16x8*)(lds + PG8_SB(b, h) + boff + n * 2048 + 1024)); \
        else { _Pragma("unroll") for (int k = 0; k < 2; ++k) dst[n][k] = *(const PG8_LAS bf16x8*)(lds + PG8_SB(b, h) + boff + n * 2048 + k * 1024); } } } while (0)
#define PG8_MMA(ai, bj, At, Bt) do { __builtin_amdgcn_s_setprio(1); _Pragma("unroll") for (int m = 0; m < 4; ++m) _Pragma("unroll") for (int n = 0; n < 2; ++n) { \
        if constexpr (F8) mfma8_tied(acc[ai][bj][m][n], Bt##8[n], At##8[m], one8); \
        else { _Pragma("unroll") for (int k = 0; k < 2; ++k) acc[ai][bj][m][n] = __builtin_amdgcn_mfma_f32_16x16x32_bf16(Bt[n][k], At[m][k], acc[ai][bj][m][n], 0, 0, 0); } } \
        __builtin_amdgcn_s_setprio(0); } while (0)
#define PG8_WAIT_V(n) asm volatile("s_waitcnt vmcnt(" #n ")" ::: "memory")
#define PG8_WAIT_L(n) asm volatile("s_waitcnt lgkmcnt(" #n ")" ::: "memory")
#define PG8_BAR __builtin_amdgcn_s_barrier()
#define PG8_SCHED __builtin_amdgcn_sched_barrier(0)
#define PG8_UA(u) (GATHER ? (const char*)Abase : (const char*)Abase + (size_t)(u).pm * tstep)
#define PG8_LOADOFF(u, v0, v1) do { _Pragma("unroll") for (int _i = 0; _i < 2; ++_i) { \
        if (GATHER) { v0[_i] = rowoff_tab[(u).slot * tab_stride + RA[_i]] + CA[_i]; v1[_i] = rowoff_tab[(u).slot * tab_stride + HALF + RA[_i]] + CA[_i]; } \
        else { v0[_i] = voffA[_i]; v1[_i] = voffA[_i] + (unsigned)hstep; } } } while (0)
    MUnit cur, nxt; int ui = 0;
    if (!S.next(0, cur)) return;
    f32x4 acc[2][2][4][2];
#pragma unroll
    for (int a = 0; a < 2; ++a)
#pragma unroll
        for (int b = 0; b < 2; ++b)
#pragma unroll
            for (int m = 0; m < 4; ++m)
#pragma unroll
                for (int n = 0; n < 2; ++n) acc[a][b][m][n] = (f32x4){0.f, 0.f, 0.f, 0.f};
    bf16x8 At[4][2], B0[2][2], B1[2][2]; v8i_ At8[4], B08[2], B18[2];
    unsigned one8 = 0x7f7f7f7fu; asm volatile("" : "+v"(one8));
    const char* cA = PG8_UA(cur); const char* cB = (const char*)cur.bt;
    unsigned cv0[2], cv1[2], nv0[2], nv1[2];
    PG8_LOADOFF(cur, cv0, cv1);
    PG8_STAGE(PG8_SB(0, 0), cB, voffB); PG8_STAGE(PG8_SB(0, 1), cB + hstep, voffB); PG8_STAGE(PG8_SA(0, 0), cA, cv0); PG8_STAGE(PG8_SA(0, 1), cA, cv1);
    if (wr == 1) PG8_BAR;
    PG8_WAIT_V(2); PG8_BAR;
    PG8_STAGE(PG8_SB(1, 0), cB + kstep, voffB); PG8_STAGE(PG8_SA(1, 0), cA + kstep, cv0); PG8_STAGE(PG8_SB(1, 1), cB + hstep + kstep, voffB);
    PG8_WAIT_V(6); PG8_BAR;
    for (;;) {
        const bool has_next = S.next(ui + 1, nxt);
        const char* nA = has_next ? PG8_UA(nxt) : cA; const char* nB = has_next ? (const char*)nxt.bt : cB;
        if (has_next) { PG8_LOADOFF(nxt, nv0, nv1); } else { _Pragma("unroll") for (int _i = 0; _i < 2; ++_i) { nv0[_i] = cv0[_i]; nv1[_i] = cv1[_i]; } }
#pragma unroll 1
        for (int t = 0; t < nt; t += 2) {
            const bool last = (t == nt - 2);
            const char* a1 = cA + (size_t)(t + 1) * kstep;
            const char* a2 = last ? nA : cA + (size_t)(t + 2) * kstep; const char* b2 = last ? nB : cB + (size_t)(t + 2) * kstep;
            const char* a3 = a2 + kstep; const char* b3 = b2 + kstep;
            unsigned x0[2], x1[2];
#pragma unroll
            for (int _i = 0; _i < 2; ++_i) { x0[_i] = last ? nv0[_i] : cv0[_i]; x1[_i] = last ? nv1[_i] : cv1[_i]; }
            PG8_LDB(B0, 0, 0); PG8_LDB(B1, 0, 1); PG8_SCHED; PG8_LDA(At, 0, 0); PG8_STAGE(PG8_SA(1, 1), a1, cv1);
            PG8_WAIT_V(8); PG8_WAIT_L(0); PG8_BAR; PG8_MMA(0, 0, At, B0); PG8_MMA(0, 1, At, B1); PG8_BAR; PG8_SCHED;
            PG8_LDA(At, 0, 1); PG8_STAGE(PG8_SB(0, 0), b2, voffB); PG8_STAGE(PG8_SB(0, 1), b2 + hstep, voffB); PG8_STAGE(PG8_SA(0, 0), a2, x0);
            PG8_WAIT_V(8); PG8_WAIT_L(0); PG8_BAR; PG8_MMA(1, 0, At, B0); PG8_MMA(1, 1, At, B1); PG8_BAR; PG8_SCHED;
            PG8_LDB(B0, 1, 0); PG8_LDB(B1, 1, 1); PG8_SCHED; PG8_LDA(At, 1, 0); PG8_STAGE(PG8_SA(0, 1), a2, x1);
            PG8_WAIT_V(8); PG8_WAIT_L(0); PG8_BAR; PG8_MMA(0, 0, At, B0); PG8_MMA(0, 1, At, B1); PG8_BAR; PG8_SCHED;
            PG8_LDA(At, 1, 1); PG8_STAGE(PG8_SB(1, 0), b3, voffB); PG8_STAGE(PG8_SB(1, 1), b3 + hstep, voffB); PG8_STAGE(PG8_SA(1, 0), a3, x0);
            PG8_WAIT_V(8); PG8_WAIT_L(0); PG8_BAR; PG8_MMA(1, 0, At, B0); PG8_MMA(1, 1, At, B1); PG8_BAR; PG8_SCHED;
        }
        if constexpr (ALIGN_EPI) { if (wr == 0) PG8_BAR; }
        if constexpr (F8) asm volatile("s_nop 15\n\ts_nop 7" ::: "memory");
        E(acc, cur, wr, wc, fr, fq);
        if (!has_next) break;
#pragma unroll
        for (int a = 0; a < 2; ++a)
#pragma unroll
            for (int b = 0; b < 2; ++b)
#pragma unroll
                for (int m = 0; m < 4; ++m)
#pragma unroll
                    for (int n = 0; n < 2; ++n) acc[a][b][m][n] = (f32x4){0.f, 0.f, 0.f, 0.f};
        cur = nxt; cA = nA; cB = nB; ++ui;
#pragma unroll
        for (int _i = 0; _i < 2; ++_i) { cv0[_i] = nv0[_i]; cv1[_i] = nv1[_i]; }
        if constexpr (ALIGN_EPI) { if (wr == 1) PG8_BAR; }
    }
    PG8_WAIT_V(0);
    if constexpr (!ALIGN_EPI) { if (wr == 0) PG8_BAR; }
    PG8_BAR;
#undef PG8_SA
#undef PG8_SB
#undef PG8_STAGE
#undef PG8_LDA
#undef PG8_LDB
#undef PG8_MMA
#undef PG8_WAIT_V
#undef PG8_WAIT_L
#undef PG8_BAR
#undef PG8_SCHED
#undef PG8_UA
#undef PG8_LOADOFF
}
}

template <class T, class = void> struct has_pre { static constexpr bool value = false; };
template <class T> struct has_pre<T, decltype((void)sizeof(typename T::Pre), void())> { static constexpr bool value = true; };
template <class Fn> struct EpiRows {
    static constexpr bool PERM = true, AFTER_DRAIN = false, PERM2 = pg8::has_perm2<Fn>::value;
    Fn f; int prow0;
    __device__ __forceinline__ void operator()(const pg8::f32x4 (&acc)[2][2][4][2], const pg8::Unit& u, int wr, int wc, int fr, int fq) const {
        if constexpr (has_pre<Fn>::value) {
            typename Fn::Pre pr[8];
#pragma unroll
            for (int i = 0; i < 8; ++i) pr[i] = f.pre(prow0 + u.pm * 256 + (i >> 2) * 128 + wr * 64 + (i & 3) * 16 + fr, u.pn, wc, fq);
#pragma unroll
            for (int i = 0; i < 8; ++i) { const int ai = i >> 2, m = i & 3; f.row(prow0 + u.pm * 256 + ai * 128 + wr * 64 + m * 16 + fr, u.pn, wc, fq, acc[ai][0][m][0], acc[ai][0][m][1], acc[ai][1][m][0], acc[ai][1][m][1], true, pr[i]); }
        } else {
#pragma unroll
        for (int ai = 0; ai < 2; ++ai)
#pragma unroll
            for (int m = 0; m < 4; ++m) f.row(prow0 + u.pm * 256 + ai * 128 + wr * 64 + m * 16 + fr, u.pn, wc, fq, acc[ai][0][m][0], acc[ai][0][m][1], acc[ai][1][m][0], acc[ai][1][m][1], true);
        }
    }
};

struct Params { const float* in[21]; float* out; unsigned char* ws; int pad0, pad1; };
enum { I_X = 0, I_META, I_GMIX, I_GFFN, I_WIN, I_CONVW, I_WOUT, I_KVG, I_WDKV, I_CKVG, I_WUKV, I_WDQ, I_CQG, I_WUQ, I_WO, I_WGRP, I_WEXP, I_WGATE, I_WUP, I_WDOWN, I_FG };

struct Frame {
    LAS unsigned char* lds;
    int tid, wave, gw, ngw;
    unsigned char* ws; const Params* P;
};
#define FIN(i) (F.P->in[i])
#define WSP(TYPE, off) ((TYPE*)(F.ws + (off)))
#define ARP(TYPE, off) ((TYPE*)(F.ws + WS_ARENA + (off)))
#define F_CTL   WSP(unsigned, WS_CTL)
#define F_STAT  WSP(float, WS_STAT)
#define F_ROPE  WSP(float, WS_ROPE)
#define F_TSLOT WSP(unsigned, WS_TSLOT)
#define F_TOK   WSP(int, WS_TOK)
#define F_WOF   WSP(float, WS_WOF)
#define F_WIN   WSP(bf16, WS_WIN)
#define F_WOUT  WSP(bf16, WS_WOUT)
#define F_WO    WSP(bf16, WS_WO)
#define F_WKVQ  WSP(bf16, WS_WKVQ)
#define F_WUKV  WSP(bf16, WS_WUKV)
#define F_WUQ   WSP(bf16, WS_WUQ)
#define F_WR    WSP(bf16, WS_WR)
#define F_WGU   WSP(bf16, WS_WGU)
#define F_WD    WSP(bf16, WS_WD)
#define F_H13   WSP(bf16, WS_H13)
#define F_H2    WSP(bf16, WS_H2)
#define F_CKV   WSP(bf16, WS_CKV)
#define F_CQ    WSP(bf16, WS_CQ)
#define F_H8    WSP(unsigned char, WS_H8)
#define F_KB    ARP(bf16, AR_K)
#define F_VB    ARP(bf16, AR_V)
#define F_QB    ARP(bf16, AR_Q)
#define F_OB    ARP(bf16, AR_O)
#define F_O8    ARP(unsigned char, AR_O)
#define F_K8    ARP(unsigned char, AR_K8)
#define F_VT8   ARP(unsigned char, AR_VT8)
#define F_Q8    ARP(unsigned char, AR_Q8)
#define F_WK    WSP(bf16, WS_WUKV)
#define F_WV    WSP(bf16, WS_WUKV + 512 * 1024)
#define F_H0B   ARP(bf16, AR_H0)
#define F_BB    ARP(bf16, AR_B)
#define F_ZB    ARP(bf16, AR_Z)
#define F_A2    ARP(bf16, AR_A2)
#define F_HH    ARP(bf16, AR_HH)
#define F_YS    ARP(bf16, AR_YS)

template <int MT>
__device__ __forceinline__ void wave_mma(const bf16* const (&arow)[MT], const bf16* bt, int K, int lane, f32x4 (&acc)[MT][2][2], int ldb = 0) {
    const int i = lane & 15, kq = lane >> 4;
    if (ldb == 0) ldb = K;
    const bf16* brow[2][2];
#pragma unroll
    for (int h = 0; h < 2; ++h)
#pragma unroll
        for (int n = 0; n < 2; ++n) brow[h][n] = bt + (size_t)(128 * h + 8 * (i >> 2) + 4 * n + (i & 3)) * ldb + kq * 8;
#pragma unroll
    for (int m = 0; m < MT; ++m)
#pragma unroll
        for (int h = 0; h < 2; ++h)
#pragma unroll
            for (int n = 0; n < 2; ++n) acc[m][h][n] = (f32x4){0.f, 0.f, 0.f, 0.f};
#pragma unroll 4
    for (int k0 = 0; k0 < K; k0 += 32) {
        bf16x8 a[MT], b[2][2];
#pragma unroll
        for (int m = 0; m < MT; ++m) a[m] = *(const bf16x8*)(arow[m] + k0 + kq * 8);
#pragma unroll
        for (int h = 0; h < 2; ++h)
#pragma unroll
            for (int n = 0; n < 2; ++n) b[h][n] = *(const bf16x8*)(brow[h][n] + k0);
#pragma unroll
        for (int m = 0; m < MT; ++m)
#pragma unroll
            for (int h = 0; h < 2; ++h)
#pragma unroll
                for (int n = 0; n < 2; ++n) acc[m][h][n] = __builtin_amdgcn_mfma_f32_16x16x32_bf16(b[h][n], a[m], acc[m][h][n], 0, 0, 0);
    }
}
template <int MT, class Epi>
__device__ __forceinline__ void sgemm(const Frame& F, const bf16* A, int lda, int M, int prow0, const bf16* Bt, int N, int K, const Epi& E) {
    const int lane_ = (opq(F.tid) & 63), fr = lane_ & 15, fq = lane_ >> 4;
    const int nrb = (M + 16 * MT - 1) / (16 * MT), ntn = N / 256, nunits = nrb * ntn * 4;
    for (int u = F.gw; u < nunits; u += F.ngw) {
        const int g = u & 3, pn = (u >> 2) % ntn, rb = (u >> 2) / ntn;
        const bf16* arow[MT]; int rr[MT];
#pragma unroll
        for (int m = 0; m < MT; ++m) { rr[m] = rb * 16 * MT + m * 16 + fr; const int rc = rr[m] < M ? rr[m] : M - 1; arow[m] = A + (size_t)rc * lda; }
        f32x4 acc[MT][2][2];
        wave_mma<MT>(arow, Bt + (size_t)(pn * 256 + g * 32) * K, K, lane_, acc);
#pragma unroll
        for (int m = 0; m < MT; ++m) E.row(prow0 + rr[m], pn, g, fq, acc[m][0][0], acc[m][0][1], acc[m][1][0], acc[m][1][1], rr[m] < M);
    }
}

__device__ __forceinline__ void st8(bf16* p, f32x4 a, f32x4 b) { *(u32x4*)p = pack8(a, b); }
__device__ __forceinline__ u32x2 pk8_fp8(f32x4 a, f32x4 b);

struct EpiIn {
    bf16* Bb; bf16* Zb; const float* rstd0;
    __device__ __forceinline__ void row(int p, int pn, int wc, int fq, f32x4 a0, f32x4 a1, f32x4 b0, f32x4 b1, bool valid) const {
        if (!valid) return;
        const float s = rstd0[p]; const int c = 32 * wc + 8 * fq;
        if (pn < 4) { st8(Bb + (size_t)p * D + 256 * pn + c, a0 * s, a1 * s); st8(Bb + (size_t)p * D + 256 * pn + 128 + c, b0 * s, b1 * s); }
        else { const float s2 = s * s; st8(Zb + (size_t)p * D + 128 * (pn - 4) + c, a0 * b0 * s2, a1 * b1 * s2); }
    }
};
struct EpiOut {
    bf16* __restrict__ H; const bf16* __restrict__ H0; unsigned char* __restrict__ H8;
    __device__ __forceinline__ void row(int p, int pn, int wc, int fq, f32x4 a0, f32x4 a1, f32x4 b0, f32x4 b1, bool valid) const {
        if (!valid) return;
        const int c = 256 * pn + 32 * wc + 8 * fq;
        const u32x4 r = *(const u32x4*)(H0 + (size_t)p * D + c), q = *(const u32x4*)(H0 + (size_t)p * D + c + 128);
        const f32x4 o0 = a0 + (f32x4){bflo(r.x), bfhi(r.x), bflo(r.y), bfhi(r.y)}, o1 = a1 + (f32x4){bflo(r.z), bfhi(r.z), bflo(r.w), bfhi(r.w)};
        const f32x4 o2 = b0 + (f32x4){bflo(q.x), bfhi(q.x), bflo(q.y), bfhi(q.y)}, o3 = b1 + (f32x4){bflo(q.z), bfhi(q.z), bflo(q.w), bfhi(q.w)};
        st8(H + (size_t)p * D + c, o0, o1); st8(H + (size_t)p * D + c + 128, o2, o3);
        *(u32x2*)(H8 + (size_t)p * D + c) = pk8_fp8(o0, o1); *(u32x2*)(H8 + (size_t)p * D + c + 128) = pk8_fp8(o2, o3);
    }
};
struct EpiRes {
    bf16* __restrict__ H; const bf16* __restrict__ Hin; unsigned char* __restrict__ H8; float sc; int pad_;
    __device__ __forceinline__ void row(int p, int pn, int wc, int fq, f32x4 a0, f32x4 a1, f32x4 b0, f32x4 b1, bool valid) const {
        if (!valid) return;
        const int c = 256 * pn + 32 * wc + 8 * fq;
        const u32x4 r = *(const u32x4*)(Hin + (size_t)p * D + c), q = *(const u32x4*)(Hin + (size_t)p * D + c + 128);
        const f32x4 o0 = a0 * sc + (f32x4){bflo(r.x), bfhi(r.x), bflo(r.y), bfhi(r.y)}, o1 = a1 * sc + (f32x4){bflo(r.z), bfhi(r.z), bflo(r.w), bfhi(r.w)};
        const f32x4 o2 = b0 * sc + (f32x4){bflo(q.x), bfhi(q.x), bflo(q.y), bfhi(q.y)}, o3 = b1 * sc + (f32x4){bflo(q.z), bfhi(q.z), bflo(q.w), bfhi(q.w)};
        st8(H + (size_t)p * D + c, o0, o1); st8(H + (size_t)p * D + c + 128, o2, o3);
        *(u32x2*)(H8 + (size_t)p * D + c) = pk8_fp8(o0, o1); *(u32x2*)(H8 + (size_t)p * D + c + 128) = pk8_fp8(o2, o3);
    }
};
__device__ __forceinline__ float sumsq8(f32x4 a, f32x4 b) { return (a[0] * a[0] + a[1] * a[1]) + (a[2] * a[2] + a[3] * a[3]) + (b[0] * b[0] + b[1] * b[1]) + (b[2] * b[2] + b[3] * b[3]); }
__device__ __forceinline__ void rope8(const float* cs, f32x4 a0, f32x4 a1, f32x4 b0, f32x4 b1, f32x4& o1a, f32x4& o1b, f32x4& o2a, f32x4& o2b) {
#pragma unroll
    for (int j = 0; j < 4; ++j) { const float c0 = cs[2 * j], s0 = cs[2 * j + 1], c1 = cs[2 * (j + 4)], s1 = cs[2 * (j + 4) + 1];
        o1a[j] = a0[j] * c0 - b0[j] * s0; o2a[j] = a0[j] * s0 + b0[j] * c0; o1b[j] = a1[j] * c1 - b1[j] * s1; o2b[j] = a1[j] * s1 + b1[j] * c1; }
}
__device__ __forceinline__ void krope_store(bf16* Kb, int p, int i0, f32x4 o1a, f32x4 o1b, f32x4 o2a, f32x4 o2b) {
    const u32x4 w1 = pack8(o1a, o1b), w2 = pack8(o2a, o2b);
#pragma unroll
    for (int h = 0; h < NH; ++h) { bf16* kr = Kb + ((size_t)h * KROWS + p + KPAD) * DQK + 128; *(u32x4*)(kr + i0) = w1; *(u32x4*)(kr + 32 + i0) = w2; }
}
__device__ __forceinline__ size_t k8_off(int h, int row, int col) { return (size_t)h * KROWS * DQK + (size_t)(row >> 6) * (64 * DQK) + (size_t)((col >> 4) * 1024 + (row & 63) * 16 + (col & 15)); }
__device__ __forceinline__ size_t vt8_off(int h, int T, int d, int slot) { return ((size_t)h * NKT + T) * 8192 + (size_t)((slot >> 4) * 2048 + d * 16 + (slot & 15)); }
__device__ __forceinline__ void krope_store8(unsigned char* K8, int p, int i0, f32x4 o1a, f32x4 o1b, f32x4 o2a, f32x4 o2b);
__device__ __forceinline__ void rope8v(const f32x4 (&r)[4], f32x4 a0, f32x4 a1, f32x4 b0, f32x4 b1, f32x4& o1a, f32x4& o1b, f32x4& o2a, f32x4& o2b) {
#pragma unroll
    for (int j = 0; j < 4; ++j) { const float c0 = r[j >> 1][2 * (j & 1)], s0 = r[j >> 1][2 * (j & 1) + 1], c1 = r[2 + (j >> 1)][2 * (j & 1)], s1 = r[2 + (j >> 1)][2 * (j & 1) + 1];
        o1a[j] = a0[j] * c0 - b0[j] * s0; o2a[j] = a0[j] * s0 + b0[j] * c0; o1b[j] = a1[j] * c1 - b1[j] * s1; o2b[j] = a1[j] * s1 + b1[j] * c1; }
}
struct EpiKvqFused {
    static constexpr bool PERM = true, AFTER_DRAIN = true;
    bf16* CKV; bf16* CQ; unsigned char* K8; const float* rstd2; float* sscq; const float* rope;
    __device__ __forceinline__ void fused(const f32x4 (&acc)[2][2][4][2], const pg8::Unit& u, int wr, int wc, int fr, int fq, LAS unsigned char* lds, int wid, int lane) const {
        LAS float* red = (LAS float*)lds;
        const int pn = u.pn;
        float sv[8];
#pragma unroll
        for (int ai = 0; ai < 2; ++ai)
#pragma unroll
            for (int m = 0; m < 4; ++m) { const int rl = ai * 128 + wr * 64 + m * 16 + fr;
                float ss = sumsq8(acc[ai][0][m][0], acc[ai][0][m][1]);
                if (pn < 2 || wc == 0) ss += sumsq8(acc[ai][1][m][0], acc[ai][1][m][1]);
                if (pn == 2 && wc == 3) ss = 0.f;
                ss += __shfl_xor(ss, 16); ss += __shfl_xor(ss, 32);
                if (fq == 0) red[rl * 4 + wc] = ss; sv[ai * 4 + m] = rstd2[NMETA + u.pm * 256 + rl]; }
        __syncthreads();
        const int c = 32 * wc + 8 * fq;
        const bool ropew = (pn == 2 && wc == 3);
        f32x4 rc[4], rn[4];
        if (ropew) { const f32x4* rp = (const f32x4*)(rope + ((size_t)(NMETA + u.pm * 256 + wr * 64 + fr) * 32 + 8 * fq) * 2);
#pragma unroll
            for (int j = 0; j < 4; ++j) rc[j] = rp[j]; }
#pragma unroll
        for (int ai = 0; ai < 2; ++ai)
#pragma unroll
            for (int m = 0; m < 4; ++m) { const int rl = ai * 128 + wr * 64 + m * 16 + fr, p = NMETA + u.pm * 256 + rl;
                const float s = sv[ai * 4 + m]; const f32x4 q = *(const LAS f32x4*)(red + rl * 4);
                if (ropew && ai * 4 + m < 7) { const int rl2 = ((ai * 4 + m + 1) >> 2) * 128 + wr * 64 + ((ai * 4 + m + 1) & 3) * 16 + fr; const f32x4* rp = (const f32x4*)(rope + ((size_t)(NMETA + u.pm * 256 + rl2) * 32 + 8 * fq) * 2);
#pragma unroll
                    for (int j = 0; j < 4; ++j) rn[j] = rp[j]; }
 const float tot = ((q[0] + q[1]) + (q[2] + q[3])) * (s * s);
                f32x4 a0 = acc[ai][0][m][0] * s, a1 = acc[ai][0][m][1] * s, b0 = acc[ai][1][m][0] * s, b1 = acc[ai][1][m][1] * s;
                if (pn == 0) { const float rn = 1.f / sqrtf(tot * (1.f / KVRANK) + EPS);
                    st8(CKV + (size_t)p * KVRANK + c, a0 * rn, a1 * rn); st8(CKV + (size_t)p * KVRANK + 128 + c, b0 * rn, b1 * rn); }
                else if (pn == 1) { st8(CQ + (size_t)p * QRANK + c, a0, a1); st8(CQ + (size_t)p * QRANK + 128 + c, b0, b1); if (wc == 0 && fq == 0) sscq[(size_t)p * 2] = tot; }
                else { if (wc == 0 && fq == 0) sscq[(size_t)p * 2 + 1] = tot;
                    if (wc < 3) { st8(CQ + (size_t)p * QRANK + 256 + c, a0, a1); if (wc == 0) st8(CQ + (size_t)p * QRANK + 352 + c, b0, b1); }
                    else { f32x4 o1a, o1b, o2a, o2b; rope8v(rc, a0, a1, b0, b1, o1a, o1b, o2a, o2b); krope_store8(K8, p, 8 * fq, o1a, o1b, o2a, o2b); } }
                asm volatile("" ::: "memory");
#pragma unroll
                for (int j = 0; j < 4; ++j) rc[j] = rn[j]; }
        __syncthreads();
    }
};
struct EpiKvUp {
    bf16* Kb; bf16* Vb;
    __device__ __forceinline__ void row(int p, int pn, int wc, int fq, f32x4 a0, f32x4 a1, f32x4 b0, f32x4 b1, bool valid) const {
        if (!valid) return;
        const int c = 32 * wc + 8 * fq;
        st8(Kb + ((size_t)pn * KROWS + p + KPAD) * DQK + c, a0, a1);
        st8(Vb + ((size_t)pn * KROWS + p + KPAD) * DV + c, b0, b1);
    }
};
struct EpiQUp {
    bf16* Qb; const float* sscq; const float* rope;
    __device__ __forceinline__ void row(int p, int pn, int wc, int fq, f32x4 a0, f32x4 a1, f32x4 b0, f32x4 b1, bool valid) const {
        if (!valid) return;
        const float* q = sscq + (size_t)p * 2; const float s = QSCALE / sqrtf((q[0] + q[1]) * (1.f / QRANK) + EPS);
        const int qr = p - NMETA;
        a0 = a0 * s; a1 = a1 * s; b0 = b0 * s; b1 = b1 * s;
        if (pn < 4) { const int c = 32 * wc + 8 * fq;
            st8(Qb + ((size_t)(2 * pn) * SEQ + qr) * DQK + c, a0, a1); st8(Qb + ((size_t)(2 * pn + 1) * SEQ + qr) * DQK + c, b0, b1); }
        else { const int h = 4 * (pn - 4) + wc, i0 = 8 * fq;
            f32x4 o1a, o1b, o2a, o2b; rope8(rope + ((size_t)p * 32 + i0) * 2, a0, a1, b0, b1, o1a, o1b, o2a, o2b);
            bf16* qp = Qb + ((size_t)h * SEQ + qr) * DQK + 128;
            st8(qp + i0, o1a, o1b); st8(qp + 32 + i0, o2a, o2b); }
    }
};

constexpr float K8SCALE = 0.25f, Q8SCALE = 4.f;
constexpr float WO8SCALE = 32.f, O8SCALE = 16.f, WGU8SCALE = 32.f, HH8SCALE = 4.f, WD8SCALE = 16.f, YS8SCALE = 16.f;
__device__ __forceinline__ unsigned pk4_fp8(float a, float b, float c, float d) { int w = 0; w = __builtin_amdgcn_cvt_pk_fp8_f32(a, b, w, false); w = __builtin_amdgcn_cvt_pk_fp8_f32(c, d, w, true); return (unsigned)w; }
__device__ __forceinline__ u32x2 pk8_fp8(f32x4 a, f32x4 b) { u32x2 w; w.x = pk4_fp8(a[0], a[1], a[2], a[3]); w.y = pk4_fp8(b[0], b[1], b[2], b[3]); return w; }
__device__ __forceinline__ int vt_slot(int kk) { const int k5 = kk & 31; return 32 * ((k5 >> 2) & 1) + ((kk & 32) >> 1) + 4 * (k5 >> 3) + (k5 & 3); }
__device__ __forceinline__ void krope_store8(unsigned char* K8, int p, int i0, f32x4 o1a, f32x4 o1b, f32x4 o2a, f32x4 o2b) {
    const u32x2 w1 = pk8_fp8(o1a * K8SCALE, o1b * K8SCALE), w2 = pk8_fp8(o2a * K8SCALE, o2b * K8SCALE);
#pragma unroll
    for (int h = 0; h < NH; ++h) { *(u32x2*)(K8 + k8_off(h, p + KPAD, 128 + i0)) = w1; *(u32x2*)(K8 + k8_off(h, p + KPAD, 160 + i0)) = w2; }
}
struct EpiKnope8 {
    unsigned char* K8;
    __device__ __forceinline__ void row(int p, int pn, int wc, int fq, f32x4 a0, f32x4 a1, f32x4 b0, f32x4 b1, bool valid) const {
        if (!valid) return;
        const int c = 32 * wc + 8 * fq;
        *(u32x2*)(K8 + k8_off(2 * pn, p + KPAD, c)) = pk8_fp8(a0 * K8SCALE, a1 * K8SCALE);
        *(u32x2*)(K8 + k8_off(2 * pn + 1, p + KPAD, c)) = pk8_fp8(b0 * K8SCALE, b1 * K8SCALE);
    }
};
struct EpiVt8 {
    static constexpr bool PERM2 = true;
    unsigned char* Vt8;
    __device__ __forceinline__ void row(int r, int pn, int wc, int fq, f32x4 a0, f32x4 a1, f32x4 b0, f32x4 b1, bool valid) const {
        if (!valid) return;
        const int hh = r >> 7, d = r & 127;
#pragma unroll
        for (int hf = 0; hf < 2; ++hf) { const int n0 = 256 * pn + 128 * hf + 32 * wc + 4 * (fq & 1) + 16 * (fq >> 1), T = (n0 >> 6) + 1, kk0 = n0 & 63;
            unsigned char* base = Vt8 + vt8_off(hh, T, d, vt_slot(kk0));
            const f32x4 lo = hf ? b0 : a0, hi = hf ? b1 : a1;
            u32x2 w; w.x = pk4_fp8(lo[0], lo[1], lo[2], lo[3]); w.y = pk4_fp8(hi[0], hi[1], hi[2], hi[3]); *(u32x2*)base = w; }
    }
};
struct EpiVt8Meta {
    unsigned char* Vt8;
    __device__ __forceinline__ void row(int p, int pn, int wc, int fq, f32x4 a0, f32x4 a1, f32x4 b0, f32x4 b1, bool valid) const {
        if (!valid) return;
        const int slot = vt_slot(KPAD + p);
#pragma unroll
        for (int hf = 0; hf < 2; ++hf) { const int hh = 2 * pn + hf, d0 = 32 * wc + 8 * fq;
#pragma unroll
            for (int j = 0; j < 8; ++j) { const float v = hf ? (j < 4 ? b0[j] : b1[j - 4]) : (j < 4 ? a0[j] : a1[j - 4]);
                Vt8[vt8_off(hh, 0, d0 + j, slot)] = (unsigned char)(__builtin_amdgcn_cvt_pk_fp8_f32(v, v, 0, false) & 0xff); } }
    }
};
struct EpiQUp8 {
    unsigned char* Q8; const float* sscq; const float* rope;
    struct Pre { float q0, q1; };
    __device__ __forceinline__ Pre pre(int p, int, int, int) const { const float* q = sscq + (size_t)p * 2; return Pre{q[0], q[1]}; }
    __device__ __forceinline__ void row(int p, int pn, int wc, int fq, f32x4 a0, f32x4 a1, f32x4 b0, f32x4 b1, bool valid, const Pre& P) const {
        if (!valid) return;
        const float s = (QSCALE * Q8SCALE) / sqrtf((P.q0 + P.q1) * (1.f / QRANK) + EPS);
        const int qr = p - NMETA;
        a0 = a0 * s; a1 = a1 * s; b0 = b0 * s; b1 = b1 * s;
        if (pn < 4) { const int c = 32 * wc + 8 * fq;
            *(u32x2*)(Q8 + ((size_t)(2 * pn) * SEQ + qr) * DQK + c) = pk8_fp8(a0, a1); *(u32x2*)(Q8 + ((size_t)(2 * pn + 1) * SEQ + qr) * DQK + c) = pk8_fp8(b0, b1); }
        else { const int h = 4 * (pn - 4) + wc, i0 = 8 * fq;
            f32x4 o1a, o1b, o2a, o2b; rope8(rope + ((size_t)p * 32 + i0) * 2, a0, a1, b0, b1, o1a, o1b, o2a, o2b);
            unsigned char* qp = Q8 + ((size_t)h * SEQ + qr) * DQK + 128;
            *(u32x2*)(qp + i0) = pk8_fp8(o1a, o1b); *(u32x2*)(qp + 32 + i0) = pk8_fp8(o2a, o2b); }
    }
};

__device__ __forceinline__ void tr_item(const float* src, int ld, int col0, const float* gain, int k0, bf16* dst, int Kd, LAS float* scr, int lane, float f8scale = 0.f) {
    (void)scr;
    const int g = lane >> 3, q = lane & 7;
    if (f8scale > 0.f) { unsigned char* d8 = (unsigned char*)dst + (size_t)(4 * q) * Kd + k0 + 8 * g;
        if (col0 < 0) {
#pragma unroll
            for (int j = 0; j < 4; ++j) *(u32x2*)(d8 + (size_t)j * Kd) = (u32x2){0u, 0u};
            return; }
        f32x4 v[8]; const float* sp = src + (size_t)(k0 + 8 * g) * ld + col0 + 4 * q;
#pragma unroll
        for (int i = 0; i < 8; ++i) v[i] = *(const f32x4*)(sp + (size_t)i * ld) * f8scale;
        if (gain) { const f32x4 g0 = *(const f32x4*)(gain + k0 + 8 * g), g1 = *(const f32x4*)(gain + k0 + 8 * g + 4);
#pragma unroll
            for (int i = 0; i < 4; ++i) { v[i] = v[i] * g0[i]; v[4 + i] = v[4 + i] * g1[i]; } }
#pragma unroll
        for (int j = 0; j < 4; ++j) { u32x2 o; o.x = pk4_fp8(v[0][j], v[1][j], v[2][j], v[3][j]); o.y = pk4_fp8(v[4][j], v[5][j], v[6][j], v[7][j]); *(u32x2*)(d8 + (size_t)j * Kd) = o; }
        return; }
    bf16* dp = dst + (size_t)(4 * q) * Kd + k0 + 8 * g;
    if (col0 < 0) {
#pragma unroll
        for (int j = 0; j < 4; ++j) *(u32x4*)(dp + (size_t)j * Kd) = (u32x4){0u, 0u, 0u, 0u};
        return;
    }
    f32x4 v[8];
    const float* sp = src + (size_t)(k0 + 8 * g) * ld + col0 + 4 * q;
#pragma unroll
    for (int i = 0; i < 8; ++i) v[i] = *(const f32x4*)(sp + (size_t)i * ld);
    if (gain) { const f32x4 g0 = *(const f32x4*)(gain + k0 + 8 * g), g1 = *(const f32x4*)(gain + k0 + 8 * g + 4);
#pragma unroll
        for (int i = 0; i < 4; ++i) { v[i] = v[i] * g0[i]; v[4 + i] = v[4 + i] * g1[i]; } }
#pragma unroll
    for (int j = 0; j < 4; ++j) { u32x4 o; o.x = cvtpk(v[0][j], v[1][j]); o.y = cvtpk(v[2][j], v[3][j]); o.z = cvtpk(v[4][j], v[5][j]); o.w = cvtpk(v[6][j], v[7][j]);
        *(u32x4*)(dp + (size_t)j * Kd) = o; }
}
constexpr int IT_GU = 16 * 8, IT_D = 32 * 2, IT_EXP = IT_GU + IT_D;
constexpr int L0_PRO = 0, L0_P1 = 40, L1_P5 = 32, L1_P8 = 12, L1_P12 = 20;
__device__ __forceinline__ void expert_item(const Frame& F, int r, LAS float* scr, int lane) {
    (void)scr;
    const int le = r / IT_EXP, q = r % IT_EXP, l = le >> 6, g = lane >> 3, qq = lane & 7;
    const float* sp; const float* gp; unsigned char* d8; int ld, Kd; float scale;
    if (q < IT_GU) { const int nb = q >> 3, kb = q & 7, n0 = nb * 32, pn = n0 >> 8, hf = (n0 >> 7) & 1, cc = n0 & 127, k0 = kb * 128;
        sp = (hf ? FIN(I_WUP) : FIN(I_WGATE)) + (size_t)le * 1024 * 256 + (size_t)(k0 + 16 * g) * 256 + 128 * pn + cc + 4 * qq; ld = 256;
        gp = FIN(I_GFFN) + l * D + k0 + 16 * g; d8 = (unsigned char*)F_WGU + ((size_t)le * 512 + n0 + 4 * qq) * 1024 + k0 + 16 * g; Kd = 1024; scale = WGU8SCALE; }
    else { const int q2 = q - IT_GU, nb = q2 >> 1, kb = q2 & 1, k0 = kb * 128;
        sp = FIN(I_WDOWN) + (size_t)le * 256 * 1024 + (size_t)(k0 + 16 * g) * 1024 + nb * 32 + 4 * qq; ld = 1024;
        gp = nullptr; d8 = (unsigned char*)F_WD + ((size_t)le * 1024 + nb * 32 + 4 * qq) * 256 + k0 + 16 * g; Kd = 256; scale = WD8SCALE; }
    f32x4 v[16], gs[4];
#pragma unroll
    for (int i = 0; i < 16; ++i) v[i] = *(const f32x4*)(sp + (size_t)i * ld);
#pragma unroll
    for (int j = 0; j < 4; ++j) gs[j] = gp ? *(const f32x4*)(gp + 4 * j) * scale : (f32x4){scale, scale, scale, scale};
#pragma unroll
    for (int j = 0; j < 4; ++j) { u32x4 o;
        o.x = pk4_fp8(v[0][j] * gs[0][0], v[1][j] * gs[0][1], v[2][j] * gs[0][2], v[3][j] * gs[0][3]); o.y = pk4_fp8(v[4][j] * gs[1][0], v[5][j] * gs[1][1], v[6][j] * gs[1][2], v[7][j] * gs[1][3]);
        o.z = pk4_fp8(v[8][j] * gs[2][0], v[9][j] * gs[2][1], v[10][j] * gs[2][2], v[11][j] * gs[2][3]); o.w = pk4_fp8(v[12][j] * gs[3][0], v[13][j] * gs[3][1], v[14][j] * gs[3][2], v[15][j] * gs[3][3]);
        *(u32x4*)(d8 + (size_t)j * Kd) = o; }
}
__device__ __forceinline__ void p0_prologue(const Frame& F) {
    LAS float* scr = (LAS float*)(F.lds + F.wave * 16384);
    const int lane = (opq(F.tid) & 63);
    constexpr int IT_WIN = 96 * 16, IT_WOUT = 32 * 16, IT_WO = 32 * 16, IT_KVQ = 24 * 16, IT_UKV = 64 * 4, IT_UQ = 48 * 6;
    constexpr int IT_SMALL = IT_WIN + IT_WOUT + IT_WO + IT_KVQ + IT_UKV + IT_UQ;
    const int IT_ALL = IT_SMALL + (gridDim.x >= 256 ? L0_PRO : L0_PRO + L0_P1) * IT_EXP;
    for (int it = F.gw; it < IT_ALL; it += F.ngw) {
        int r = it;
        if (r < IT_WIN) { const int nb = r >> 4, kb = r & 15, n0 = nb * 32, pn = n0 >> 8, hf = (n0 >> 7) & 1, c = n0 & 127;
            const int col = (pn < 4) ? (256 * pn + 128 * hf + c) : ((hf ? 2048 : 1024) + 128 * (pn - 4) + c);
            tr_item(FIN(I_WIN), 3072, col, FIN(I_GMIX), kb * 64, F_WIN + (size_t)n0 * 1024, 1024, scr, lane); continue; } r -= IT_WIN;
        if (r < IT_WOUT) { const int nb = r >> 4, kb = r & 15; tr_item(FIN(I_WOUT), 1024, nb * 32, nullptr, kb * 64, F_WOUT + (size_t)nb * 32 * 1024, 1024, scr, lane); continue; } r -= IT_WOUT;
        if (r < IT_WO) { const int nb = r >> 4, kb = r & 15; tr_item(FIN(I_WO), 1024, nb * 32, nullptr, kb * 64, (bf16*)((unsigned char*)F_WO + (size_t)nb * 32 * 1024), 1024, scr, lane, WO8SCALE); continue; } r -= IT_WO;
        if (r < IT_KVQ) { const int nb = r >> 4, kb = r & 15, n0 = nb * 32; bf16* dst = F_WKVQ + (size_t)n0 * 1024;
            const float* gq = FIN(I_GMIX) + D;
            if (n0 < 256) tr_item(FIN(I_WDKV), 320, n0, FIN(I_KVG), kb * 64, dst, 1024, scr, lane);
            else if (n0 < 512) tr_item(FIN(I_WDQ), 384, n0 - 256, gq, kb * 64, dst, 1024, scr, lane);
            else { const int w = n0 - 512, hf = w >> 7, c = w & 127;
                if (hf == 0) { if (c < 96) tr_item(FIN(I_WDQ), 384, 256 + c, gq, kb * 64, dst, 1024, scr, lane); else tr_item(FIN(I_WDKV), 320, 256, FIN(I_KVG), kb * 64, dst, 1024, scr, lane); }
                else { if (c < 32) tr_item(FIN(I_WDQ), 384, 352, gq, kb * 64, dst, 1024, scr, lane); else if (c < 96) tr_item(FIN(I_WDQ), 384, -1, nullptr, kb * 64, dst, 1024, scr, lane); else tr_item(FIN(I_WDKV), 320, 288, FIN(I_KVG), kb * 64, dst, 1024, scr, lane); } }
            continue; } r -= IT_KVQ;
        if (r < IT_UKV) { const int nb = r >> 2, kb = r & 3, n0 = nb * 32, hh = n0 >> 8, w = n0 & 255;
            tr_item(FIN(I_WUKV), 2048, n0, FIN(I_CKVG), kb * 64, (w < 128 ? F_WK : F_WV) + (size_t)(hh * 128 + (w & 127)) * 256, 256, scr, lane); continue; } r -= IT_UKV;
        if (r < IT_UQ) { const int nb = r / 6, kb = r % 6, n0 = nb * 32; int col;
            if (n0 < 1024) { const int pn = n0 >> 8, hf = (n0 >> 7) & 1, c = n0 & 127; col = (2 * pn + hf) * 192 + c; }
            else { const int w = n0 - 1024, t = w >> 8, hf = (w >> 7) & 1, c = w & 127, hh = c >> 5; col = (4 * t + hh) * 192 + 128 + 32 * hf; }
            tr_item(FIN(I_WUQ), 1536, col, FIN(I_CQG), kb * 64, F_WUQ + (size_t)n0 * 384, 384, scr, lane); continue; } r -= IT_UQ;
        expert_item(F, r, scr, lane);
    }
    { const int gt = F.gw * 64 + lane, ngt = F.ngw * 64;
      for (int idx = gt; idx < 2 * 96 * 1024; idx += ngt) { const int l = idx / (96 * 1024), rem = idx % (96 * 1024), n = rem >> 10, k = rem & 1023;
          float v = 0.f; if (n < 8) v = FIN(I_WGRP)[((size_t)l * 1024 + k) * 8 + n]; else if (n < 72) v = FIN(I_WEXP)[((size_t)l * 1024 + k) * 64 + (n - 8)];
          v *= FIN(I_GFFN)[l * D + k]; F_WR[idx] = (bf16)(cvtpk(v, 0.f) & 0xffffu); }
      for (int idx = gt; idx < T * 32; idx += ngt) { const int p = idx >> 5, i = idx & 31; const float ang = (float)p * ROPE_INV[i];
          const double rev = (double)ang * 0.15915494309189535; const float fr = (float)(rev - __builtin_rint(rev));
          F_ROPE[2 * idx] = __builtin_amdgcn_cosf(fr); F_ROPE[2 * idx + 1] = __builtin_amdgcn_sinf(fr); } }
    for (int p = F.gw; p < T; p += F.ngw) { const float* src = (p < NMETA) ? FIN(I_META) + (size_t)p * D : FIN(I_X) + (size_t)(p - NMETA) * D;
        f32x4 v[4]; float s = 0.f;
#pragma unroll
        for (int j = 0; j < 4; ++j) { v[j] = *(const f32x4*)(src + 4 * lane + 256 * j); s += (v[j][0] * v[j][0] + v[j][1] * v[j][1]) + (v[j][2] * v[j][2] + v[j][3] * v[j][3]); }
        s = wave_sum(s);
#pragma unroll
        for (int j = 0; j < 4; ++j) { u32x2 w; w.x = cvtpk(v[j][0], v[j][1]); w.y = cvtpk(v[j][2], v[j][3]); *(u32x2*)(F_H0B + (size_t)p * D + 4 * lane + 256 * j) = w; }
        if (lane == 0) F_STAT[ST_RSTD0 + p] = 1.f / sqrtf(s * (1.f / D) + EPS); }
}

__device__ __forceinline__ void conv_phase(const Frame& F) {
    const int lane = (opq(F.tid) & 63), c0 = lane * 16;
    float cw[3][16];
#pragma unroll
    for (int t = 0; t < 3; ++t)
#pragma unroll
        for (int j = 0; j < 16; ++j) cw[t][j] = FIN(I_CONVW)[t * D + c0 + j];
    for (int p = F.gw; p < T; p += F.ngw) {
#pragma unroll
        for (int hf = 0; hf < 2; ++hf) { const int c = c0 + 8 * hf;
            float z0[8], z1[8], z2[8], b[8];
            unpack8(*(const u32x4*)(F_ZB + (size_t)p * D + c), z2); unpack8(*(const u32x4*)(F_BB + (size_t)p * D + c), b);
            if (p >= 1) unpack8(*(const u32x4*)(F_ZB + (size_t)(p - 1) * D + c), z1); else { for (int j = 0; j < 8; ++j) z1[j] = 0.f; }
            if (p >= 2) unpack8(*(const u32x4*)(F_ZB + (size_t)(p - 2) * D + c), z0); else { for (int j = 0; j < 8; ++j) z0[j] = 0.f; }
            float o[8];
#pragma unroll
            for (int j = 0; j < 8; ++j) o[j] = b[j] * (cw[0][8 * hf + j] * z0[j] + cw[1][8 * hf + j] * z1[j] + cw[2][8 * hf + j] * z2[j]);
            *(u32x4*)(F_A2 + (size_t)p * D + c) = pack8((f32x4){o[0], o[1], o[2], o[3]}, (f32x4){o[4], o[5], o[6], o[7]}); }
    }
}

constexpr int RT_ROWB = 1040, RT_SCR = 80 * RT_ROWB, RT_LCNT = MISC_OFF + 1024;
__device__ __forceinline__ void router_phase(const Frame& F, const bf16* Hb, const bf16* Wr, float* rstd_out, unsigned* cnt, int p_lo, int host_first, int host_n) {
    const int tid = opq(F.tid), lane = tid & 63, fr = lane & 15, fq = lane >> 4;
    const int nblk = (T - p_lo + 15) / 16;
    if ((int)blockIdx.x * NWAVES >= nblk) {
        { const int first = (nblk + NWAVES - 1) / NWAVES, nfree = (int)gridDim.x - first, rank = (int)blockIdx.x - first;
            for (int it = rank * NWAVES + F.wave; it < host_n; it += nfree * NWAVES) expert_item(F, host_first + it, nullptr, lane); }
        return; }
    const int blk = blockIdx.x * NWAVES + F.wave;
    const int p = p_lo + blk * 16 + fr; const bool valid = (blk < nblk) && (p < T); const int pc = valid ? p : T - 1;
    LAS float* scr = (LAS float*)(F.lds + RT_SCR + F.wave * 5376);
    LAS int* lcnt = (LAS int*)(F.lds + RT_LCNT); LAS int* lbase = lcnt + 64;
    if (tid < 64) lcnt[tid] = 0;
    f32x4 acc[5]; float ss = 0.f;
#pragma unroll
    for (int n = 0; n < 5; ++n) acc[n] = (f32x4){0.f, 0.f, 0.f, 0.f};
    const bf16* arow = Hb + (size_t)pc * D + fq * 8;
#pragma unroll 1
    for (int half = 0; half < 2; ++half) {
        bf16x8 a[16];
#pragma unroll
        for (int ks = 0; ks < 16; ++ks) a[ks] = *(const bf16x8*)(arow + half * 512 + ks * 32);
        u32x4 wv[10];
#pragma unroll
        for (int i = 0; i < 10; ++i) { const int id = tid + NTHREADS * i, row = id >> 6, ch = id & 63; wv[i] = *(const u32x4*)(Wr + (size_t)row * D + half * 512 + ch * 8); }
        __syncthreads();
#pragma unroll
        for (int i = 0; i < 10; ++i) { const int id = tid + NTHREADS * i, row = id >> 6, ch = id & 63; *(LAS u32x4*)(F.lds + row * RT_ROWB + ch * 16) = wv[i]; }
        __syncthreads();
#pragma unroll
        for (int ks = 0; ks < 16; ++ks) {
            float av[8]; unpack8(__builtin_bit_cast(u32x4, a[ks]), av);
#pragma unroll
            for (int t = 0; t < 8; ++t) ss += av[t] * av[t];
#pragma unroll
            for (int n = 0; n < 5; ++n) { const bf16x8 b = *(const LAS bf16x8*)(F.lds + (16 * n + fr) * RT_ROWB + ks * 64 + fq * 16); acc[n] = __builtin_amdgcn_mfma_f32_16x16x32_bf16(b, a[ks], acc[n], 0, 0, 0); }
        }
    }
    ss += __shfl_xor(ss, 16); ss += __shfl_xor(ss, 32);
    const float rs = 1.f / sqrtf(ss * (1.f / D) + EPS);
#pragma unroll
    for (int n = 0; n < 5; ++n)
#pragma unroll
        for (int t = 0; t < 4; ++t) scr[fr * 84 + 16 * n + 4 * fq + t] = acc[n][t] * rs;
    LDS_WAIT();
    int ea = 0, eb = 0, ra = 0, rb = 0; float w0 = 0.f, w1 = 0.f;
    const bool sel = valid && lane < 16;
    if (lane < 16) {
        const LAS float* L = scr + lane * 84;
        int g = 0; float mg = L[0];
#pragma unroll
        for (int j = 1; j < 8; ++j) { const float v = L[j]; if (v > mg) { mg = v; g = j; } }
        float sg = 0.f;
#pragma unroll
        for (int j = 0; j < 8; ++j) sg += expf(L[j] - mg);
        const float pg = 1.f / sg;
        const LAS float* Le = L + 8 + g * 8;
        int i0 = 0; float m0 = Le[0];
#pragma unroll
        for (int j = 1; j < 8; ++j) { const float v = Le[j]; if (v > m0) { m0 = v; i0 = j; } }
        int i1 = 0; float m1 = -__builtin_inff();
#pragma unroll
        for (int j = 0; j < 8; ++j) { const float v = Le[j]; if (j != i0 && v > m1) { m1 = v; i1 = j; } }
        const float e1 = expf(m1 - m0); w0 = pg / (1.f + e1); w1 = pg * e1 / (1.f + e1);
        ea = g * 8 + i0; eb = g * 8 + i1;
        if (sel) { ra = __hip_atomic_fetch_add(&lcnt[ea], 1, __ATOMIC_RELAXED, __HIP_MEMORY_SCOPE_WORKGROUP); rb = __hip_atomic_fetch_add(&lcnt[eb], 1, __ATOMIC_RELAXED, __HIP_MEMORY_SCOPE_WORKGROUP); }
    }
    __syncthreads();
    if (tid < 64) { const int c = lcnt[tid]; lbase[tid] = c > 0 ? (int)atomicAdd(&cnt[tid], (unsigned)c) : 0; }
    __syncthreads();
    if (sel) {
        rstd_out[p] = rs;
        const unsigned sa = (unsigned)(lbase[ea] + ra), sb = (unsigned)(lbase[eb] + rb);
        F_TOK[(size_t)ea * CAP + sa] = p; F_WOF[(size_t)ea * CAP + sa] = w0;
        F_TOK[(size_t)eb * CAP + sb] = p; F_WOF[(size_t)eb * CAP + sb] = w1;
        F_TSLOT[2 * p] = ((unsigned)ea << 16) | sa; F_TSLOT[2 * p + 1] = ((unsigned)eb << 16) | sb;
    }
    __syncthreads();
}

__device__ __forceinline__ void moe_tables(const Frame& F, const unsigned* cnt) {
    LAS int* cn = (LAS int*)(F.lds + MISC_OFF + 256); LAS int* pb = cn + 64;
    __syncthreads();
    if (F.tid < 64) { const int c = (int)__hip_atomic_load(cnt + F.tid, __ATOMIC_RELAXED, __HIP_MEMORY_SCOPE_AGENT), v = (c + 255) >> 8; int incl = v;
#pragma unroll
        for (int d = 1; d < 64; d <<= 1) { const int t = __shfl_up(incl, d); if ((int)F.tid >= d) incl += t; }
        cn[F.tid] = c; pb[F.tid] = incl - v; if (F.tid == 63) pb[NE] = incl; }
    __syncthreads();
}
__device__ __forceinline__ int moe_find(const LAS int* pb, int panel) { const int l = (int)(threadIdx.x & 63); const bool le = (l < NE - 1) && (pb[l + 1] <= panel); return (int)__popcll(__ballot(le)); }


constexpr int MOE_REC = MISC_OFF + 1024, MOE_TAB = MISC_OFF + 2048, MOE_SLOTS = 4;
struct MoeOrder {
    const LAS int* rec; const bf16* W; size_t estride; int K;
    __device__ __forceinline__ bool next(int i, pg8::MUnit& u) const {
        if (i >= MOE_SLOTS) return false; const LAS int* r = rec + 4 * i; if (r[3] == 0) return false;
        u.pm = r[0]; u.pn = r[1]; u.slot = i; u.bt = W + (size_t)r[2] * estride + (size_t)r[1] * 256 * K; return true; }
};
template <bool GU>
__device__ __forceinline__ void moe_fill(const Frame& F, int vcu, const float* rstd) {
    const LAS int* cn = (const LAS int*)(F.lds + MISC_OFF + 256); const LAS int* pb = cn + 64;
    LAS int* rec = (LAS int*)(F.lds + MOE_REC);
    const int npn = GU ? 2 : 4, nunits = pb[NE] * npn, tid = opq(F.tid);
    int pan_[MOE_SLOTS], pn_[MOE_SLOTS], e_[MOE_SLOTS], i_[MOE_SLOTS]; bool ok_[MOE_SLOTS], val_[MOE_SLOTS];
#pragma unroll
    for (int s = 0; s < MOE_SLOTS; ++s) { const int L = s * (int)gridDim.x + vcu; ok_[s] = L < nunits; const int Lc = ok_[s] ? L : 0;
        pan_[s] = Lc / npn; pn_[s] = Lc % npn; e_[s] = moe_find(pb, pan_[s]); i_[s] = (pan_[s] - pb[e_[s]]) * 256 + tid; val_[s] = ok_[s] && tid < 256 && i_[s] < cn[e_[s]];
        if (tid == 0) { rec[4 * s] = pan_[s]; rec[4 * s + 1] = pn_[s]; rec[4 * s + 2] = e_[s]; rec[4 * s + 3] = ok_[s] ? 1 : 0; } }
    if (GU) { int tok_[MOE_SLOTS]; float r_[MOE_SLOTS];
#pragma unroll
        for (int s = 0; s < MOE_SLOTS; ++s) tok_[s] = val_[s] ? F_TOK[(size_t)e_[s] * CAP + i_[s]] : 0;
#pragma unroll
        for (int s = 0; s < MOE_SLOTS; ++s) r_[s] = val_[s] ? rstd[tok_[s]] : 0.f;
#pragma unroll
        for (int s = 0; s < MOE_SLOTS; ++s) if (ok_[s] && tid < 256) { LAS unsigned* ro = (LAS unsigned*)(F.lds + MOE_TAB + s * 2048); LAS float* sc = (LAS float*)(ro + 256);
            ro[tid] = (unsigned)tok_[s] * (unsigned)D; sc[tid] = val_[s] ? r_[s] * (1.f / WGU8SCALE) : -1.f; }
    } else { float w_[MOE_SLOTS];
#pragma unroll
        for (int s = 0; s < MOE_SLOTS; ++s) w_[s] = val_[s] ? F_WOF[(size_t)e_[s] * CAP + i_[s]] : 0.f;
#pragma unroll
        for (int s = 0; s < MOE_SLOTS; ++s) if (ok_[s] && tid < 256) { LAS unsigned* ro = (LAS unsigned*)(F.lds + MOE_TAB + s * 2048); LAS float* sc = (LAS float*)(ro + 256);
            ro[tid] = 0u; sc[tid] = val_[s] ? w_[s] * (YS8SCALE / (HH8SCALE * WD8SCALE)) : -1.f; } }
    __syncthreads();
}
struct EpiMoeGU {
    static constexpr bool PERM = true, AFTER_DRAIN = false;
    bf16* HH; const LAS float* tab;
    __device__ __forceinline__ void operator()(const f32x4 (&acc)[2][2][4][2], const pg8::MUnit& u, int wr, int wc, int fr, int fq) const {
#pragma unroll
        for (int ai = 0; ai < 2; ++ai)
#pragma unroll
            for (int m = 0; m < 4; ++m) { const int rl = ai * 128 + wr * 64 + m * 16 + fr; const float s = tab[u.slot * 512 + 256 + rl];
                if (s > 0.f) { f32x4 o[2];
#pragma unroll
                    for (int n = 0; n < 2; ++n)
#pragma unroll
                        for (int j = 0; j < 4; ++j) { const float gg = acc[ai][0][m][n][j] * s, uu = acc[ai][1][m][n][j] * s; o[n][j] = gg * __builtin_amdgcn_rcpf(1.f + __expf(-gg)) * uu; }
                    *(u32x2*)((unsigned char*)HH + ((size_t)u.pm * 256 + rl) * DE + 128 * u.pn + 32 * wc + 8 * fq) = pk8_fp8(o[0] * HH8SCALE, o[1] * HH8SCALE); } }
    }
};
struct EpiMoeDown {
    static constexpr bool PERM = true, AFTER_DRAIN = false;
    bf16* YS; const LAS float* tab;
    __device__ __forceinline__ void operator()(const f32x4 (&acc)[2][2][4][2], const pg8::MUnit& u, int wr, int wc, int fr, int fq) const {
#pragma unroll
        for (int ai = 0; ai < 2; ++ai)
#pragma unroll
            for (int m = 0; m < 4; ++m) { const int rl = ai * 128 + wr * 64 + m * 16 + fr; const float w = tab[u.slot * 512 + 256 + rl];
                if (w > 0.f) { unsigned char* yp = (unsigned char*)YS + ((size_t)u.pm * 256 + rl) * D + 256 * u.pn + 32 * wc + 8 * fq;
                    *(u32x2*)yp = pk8_fp8(acc[ai][0][m][0] * w, acc[ai][0][m][1] * w); *(u32x2*)(yp + 128) = pk8_fp8(acc[ai][1][m][0] * w, acc[ai][1][m][1] * w); } }
    }
};
__device__ __forceinline__ int frame_vcu() { const int G = (int)gridDim.x, bx = (int)blockIdx.x; return (G % 8 == 0) ? (bx % 8) * (G / 8) + bx / 8 : bx; }
__device__ __forceinline__ void moe_gu_fast(const Frame& F, const bf16* Hb, const float* rstd, int layer) {
    moe_fill<true>(F, frame_vcu(), rstd);
    const MoeOrder S{(const LAS int*)(F.lds + MOE_REC), F_WGU + (size_t)layer * NE * 512 * 512, (size_t)512 * 512, 512};
    const EpiMoeGU E{F_HH, (const LAS float*)(F.lds + MOE_TAB)};
    pg8::gemm_phase_moe<EpiMoeGU, MoeOrder, true, true, true>(F.lds, (const bf16*)F_H8, 512, S, E, (const LAS unsigned*)(F.lds + MOE_TAB), 512);
    if (layer == 0) {
        const LAS int* pb = (const LAS int*)(F.lds + MISC_OFF + 256) + 64;
        const int G = (int)gridDim.x, nun = pb[NE] * 2, vcu = frame_vcu();
        const int first_free = nun > G ? (nun - G < G ? nun - G : G) : (nun < G ? nun : G);
        int nfree = G - first_free, rank = vcu - first_free;
        if (nfree <= 0) { nfree = G; rank = vcu; }
        if (rank >= 0) { const int lane = opq(F.tid) & 63;
            for (int it = rank * NWAVES + F.wave; it < L1_P5 * IT_EXP; it += nfree * NWAVES) expert_item(F, NE * IT_EXP + it, nullptr, lane); }
    }
}
__device__ __forceinline__ void moe_down_fast(const Frame& F, int layer) {
    moe_fill<false>(F, frame_vcu(), nullptr);
    const MoeOrder S{(const LAS int*)(F.lds + MOE_REC), F_WD + (size_t)layer * NE * 1024 * 128, (size_t)1024 * 128, 128};
    const EpiMoeDown E{F_YS, (const LAS float*)(F.lds + MOE_TAB)};
    pg8::gemm_phase_moe<EpiMoeDown, MoeOrder, true, false, true>(F.lds, F_HH, 128, S, E, (const LAS unsigned*)(F.lds + MOE_TAB), 512);
}

template <bool FINAL>
__device__ __forceinline__ void combine_phase(const Frame& F, const bf16* Hin, bf16* Hout, float* rstd_out, int p_lo) {
    const LAS int* pb = (const LAS int*)(F.lds + MISC_OFF + 256) + 64;
    const int lane = (opq(F.tid) & 63), c0 = lane * 16;
    for (int p = p_lo + F.gw; p < T; p += F.ngw) {
        const unsigned s0 = F_TSLOT[2 * p], s1 = F_TSLOT[2 * p + 1];
        const size_t r0 = (size_t)pb[s0 >> 16] * 256 + (s0 & 0xffffu), r1 = (size_t)pb[s1 >> 16] * 256 + (s1 & 0xffffu);
        float v[16]; float ss = 0.f;
        const u32x4 q0 = *(const u32x4*)((const unsigned char*)F_YS + r0 * D + c0), q1 = *(const u32x4*)((const unsigned char*)F_YS + r1 * D + c0);
        float y[16];
#pragma unroll
        for (int w = 0; w < 4; ++w) { const unsigned a_ = q0[w], b_ = q1[w];
            y[4 * w] = __builtin_amdgcn_cvt_f32_fp8(a_, 0) + __builtin_amdgcn_cvt_f32_fp8(b_, 0); y[4 * w + 1] = __builtin_amdgcn_cvt_f32_fp8(a_, 1) + __builtin_amdgcn_cvt_f32_fp8(b_, 1);
            y[4 * w + 2] = __builtin_amdgcn_cvt_f32_fp8(a_, 2) + __builtin_amdgcn_cvt_f32_fp8(b_, 2); y[4 * w + 3] = __builtin_amdgcn_cvt_f32_fp8(a_, 3) + __builtin_amdgcn_cvt_f32_fp8(b_, 3); }
#pragma unroll
        for (int hf = 0; hf < 2; ++hf) { float a[8];
            unpack8(*(const u32x4*)(Hin + (size_t)p * D + c0 + 8 * hf), a);
#pragma unroll
            for (int j = 0; j < 8; ++j) { const float t = a[j] + y[8 * hf + j] * (1.f / YS8SCALE); v[8 * hf + j] = t; ss += t * t; } }
        ss = wave_sum(ss);
        const float rs = 1.f / sqrtf(ss * (1.f / D) + EPS);
        if constexpr (FINAL) {
            float* o = F.P->out + (size_t)(p - NMETA) * D + c0; const float* fg = FIN(I_FG) + c0;
#pragma unroll
            for (int j = 0; j < 4; ++j) { const f32x4 g4 = *(const f32x4*)(fg + 4 * j); *(f32x4*)(o + 4 * j) = (f32x4){v[4 * j] * rs * g4[0], v[4 * j + 1] * rs * g4[1], v[4 * j + 2] * rs * g4[2], v[4 * j + 3] * rs * g4[3]}; }
        } else {
            *(u32x4*)(Hout + (size_t)p * D + c0) = pack8((f32x4){v[0], v[1], v[2], v[3]}, (f32x4){v[4], v[5], v[6], v[7]});
            *(u32x4*)(Hout + (size_t)p * D + c0 + 8) = pack8((f32x4){v[8], v[9], v[10], v[11]}, (f32x4){v[12], v[13], v[14], v[15]});
            if (lane == 0) rstd_out[p] = rs;
        }
    }
}


typedef int v8i __attribute__((ext_vector_type(8)));
#define MFMA_F8(A, B, C, AFMT) __builtin_amdgcn_mfma_scale_f32_32x32x64_f8f6f4((A), (B), (C), (AFMT), 0, 0, 0x7f7f7f7f, 0, 0x7f7f7f7f)
__device__ __forceinline__ v8i ld32(const unsigned char* p) { const u32x4 a = *(const u32x4*)p, b = *(const u32x4*)(p + 16); return (v8i){(int)a.x, (int)a.y, (int)a.z, (int)a.w, (int)b.x, (int)b.y, (int)b.z, (int)b.w}; }
namespace att8 {
typedef __attribute__((address_space(3))) const char* lds_cptr;
constexpr int KT = 12288, VT = 8192;
constexpr int L_K = 0, L_V = 3 * KT, L_WS = L_V + 4 * VT, L_OST = L_WS + NWAVES * 256, L_END = L_OST + NWAVES * 4096;
constexpr float BIAS8 = 0.f, THR8 = 15.f;
#define ATT_SBAR() __builtin_amdgcn_sched_barrier(0)
#define ATT_WAIT_BAR(N) asm volatile("s_waitcnt vmcnt(" #N ") lgkmcnt(0)\n\ts_barrier" ::: "memory")
__device__ __forceinline__ void glds16s(const void* sbase, unsigned voff, unsigned lds_dst) { unsigned keep;
    asm volatile("s_mov_b32 %0, m0\n\ts_mov_b32 m0, %3\n\ts_nop 0\n\tglobal_load_lds_dwordx4 %1, %2\n\ts_mov_b32 m0, %0" : "=&s"(keep) : "v"(voff), "s"(sbase), "s"(lds_dst) : "memory"); }
__device__ __forceinline__ v8i lds32(lds_cptr p, int second) { const u32x4 a = *(const __attribute__((address_space(3))) u32x4*)p, b = *(const __attribute__((address_space(3))) u32x4*)(p + second);
    return (v8i){(int)a.x, (int)a.y, (int)a.z, (int)a.w, (int)b.x, (int)b.y, (int)b.z, (int)b.w}; }
__device__ __forceinline__ float rowmax32(const f32x16& p0, const f32x16& p1) {
    float pmax = p0[0];
#pragma unroll
    for (int r = 1; r < 16; ++r) pmax = fmaxf(pmax, p0[r]);
#pragma unroll
    for (int r = 0; r < 16; ++r) pmax = fmaxf(pmax, p1[r]);
    auto rr = __builtin_amdgcn_permlane32_swap(__float_as_uint(pmax), __float_as_uint(pmax), false, false); return fmaxf(__uint_as_float(rr[0]), __uint_as_float(rr[1]));
}
__device__ __forceinline__ void mask_tile(f32x16& p0, f32x16& p1, int kidx0, int hi, int lo_k, int qidx) {
    const float NEG = -__builtin_inff();
#pragma unroll
    for (int r = 0; r < 16; ++r) { const int kx = kidx0 + crow(r, hi);
        if (kx < lo_k || kx > qidx) p0[r] = NEG;
        if (kx + 32 < lo_k || kx + 32 > qidx) p1[r] = NEG; }
}
#define pk2_bf8(a, b, old, hiword) __builtin_amdgcn_cvt_pk_bf8_f32((a), (b), (old), (hiword))

__device__ __forceinline__ void attn_unit(int h, int qb, const unsigned char* Q8, const unsigned char* K8, const unsigned char* Vt8, bf16* Ob, char* shm, int lane_in, int wid, v8i (&qr)[3], bool pre, int qb_next) {
    const int lane = opq(lane_in), r32 = lane & 31, hi = lane >> 5;
    const unsigned lds0 = (unsigned)(uintptr_t)shm;
    const lds_cptr shm3 = (lds_cptr)shm;
    LAS float* wsf = (LAS float*)(shm + L_WS) + wid * 64;
    const unsigned char* Kh = K8 + (size_t)h * KROWS * DQK; const unsigned char* Vh = Vt8 + (size_t)h * NKT * 128 * 64;
    const unsigned kvo = (unsigned)lane * 16u, vvo = (unsigned)lane * 16u;
    const bool k1 = wid < 4;
    const int jv = k1 ? wid + 4 : wid - 4;
    const unsigned gk0 = 1024u * wid, dk0 = L_K + 1024u * wid, gk1 = 1024u * (8 + wid), dk1 = L_K + 1024u * (8 + wid);
    const unsigned gv = (unsigned)(2048 * (jv >> 1) + 1024 * (jv & 1)), dv = (unsigned)(L_V + 2048 * (jv >> 1) + 1024 * (jv & 1));
#define A8_KB(t) ((const char*)Kh + (size_t)(t) * (64 * DQK))
#define A8_VB(t) ((const char*)Vh + (size_t)(t) * (128 * 64))
#define A8_DMA_K0(t, koff) glds16s(A8_KB(t) + gk0, kvo, (unsigned)__builtin_amdgcn_readfirstlane(lds0 + dk0 + (koff)))
#define A8_DMA_K1(t, koff) do { if (k1) glds16s(A8_KB(t) + gk1, kvo, (unsigned)__builtin_amdgcn_readfirstlane(lds0 + dk1 + (koff))); } while (0)
#define A8_DMA_V(t, voff) glds16s(A8_VB(t) + gv, vvo, (unsigned)__builtin_amdgcn_readfirstlane(lds0 + dv + (voff)))
    const lds_cptr kp0 = shm3 + L_K + hi * 2048 + r32 * 16;
    const lds_cptr vp0 = shm3 + L_V + hi * 4096 + r32 * 16;
    const int NT = 4 * qb + 5;
    const int qidx = KPAD + NMETA + qb * 256 + wid * 32 + r32;
    if (!pre) { A8_DMA_K0(0, 0); A8_DMA_K1(0, 0); A8_DMA_V(0, 0); A8_DMA_K0(1, KT); A8_DMA_K1(1, KT);
      const unsigned char* Qw = Q8 + ((size_t)h * SEQ + qb * 256 + wid * 32 + r32) * DQK + 32 * hi;
#pragma unroll
      for (int s = 0; s < 3; ++s) qr[s] = ld32(Qw + 64 * s); }
    float l_reg = 0.f; f32x16 o[4];
#pragma unroll
    for (int d0 = 0; d0 < 4; ++d0)
#pragma unroll
        for (int r = 0; r < 16; ++r) o[d0][r] = 0.f;
    f32x16 pA0, pA1, pB0, pB1, negm;
#pragma unroll
    for (int r = 0; r < 16; ++r) negm[r] = 0.f;
    int vs_prev = 0, vs_cur = 0, vs_next = VT, ks_cur = 0, ks_nxt = KT, ks_n2 = 2 * KT;
#define A8_ROT() do { vs_prev = vs_cur; vs_cur = vs_next; vs_next = (vs_next == 3 * VT) ? 0 : vs_next + VT; \
        ks_cur = ks_nxt; ks_nxt = ks_n2; ks_n2 = (ks_n2 == 2 * KT) ? 0 : ks_n2 + KT; } while (0)
#define A8_KFRAG(i, kb_) lds32((kb_) + ((i) >> 1) * 4096 + ((i) & 1) * 512, 1024)
#define A8_VFRAG(d, vb_) lds32((vb_) + (d) * 512, 2048)
#define A8_MIDBAR(t) do { if ((t) + 2 < NT) { if (k1) { ATT_WAIT_BAR(3); } else { ATT_WAIT_BAR(2); } } else if ((t) + 1 < NT) { ATT_WAIT_BAR(1); } else { ATT_WAIT_BAR(0); } } while (0)
    ATT_WAIT_BAR(0);
    asm volatile("" : "+v"(qr[0]), "+v"(qr[1]), "+v"(qr[2]));
    A8_DMA_K0(2, 2 * KT); A8_DMA_K1(2, 2 * KT); A8_DMA_V(1, VT);
#pragma unroll
    for (int s = 0; s < 3; ++s) { pA0 = MFMA_F8(lds32(kp0 + s * 4096, 1024), qr[s], s ? pA0 : negm, 0); pA1 = MFMA_F8(lds32(kp0 + s * 4096 + 512, 1024), qr[s], s ? pA1 : negm, 0); }
    mask_tile(pA0, pA1, 0, hi, KPAD, qidx);
    { const float m0 = rowmax32(pA0, pA1) - BIAS8;
#pragma unroll
      for (int r = 0; r < 16; ++r) { negm[r] = -m0; pA0[r] -= m0; pA1[r] -= m0; } }
#pragma unroll
    for (int r = 0; r < 16; ++r) pA0[r] = __builtin_amdgcn_exp2f(pA0[r]);
    A8_MIDBAR(0);
    A8_ROT();
    v8i kf[3], vf[3], pp = {0, 0, 0, 0, 0, 0, 0, 0};
    kf[0] = A8_KFRAG(0, kp0 + ks_cur); kf[1] = A8_KFRAG(1, kp0 + ks_cur);
#define A8_STEP(PX0, PX1, PY0, PY1, t) do { \
        float ps_ = 0.f; const lds_cptr kb_ = kp0 + ks_cur; const lds_cptr vb_ = vp0 + vs_prev; \
        _Pragma("unroll") for (int i = 0; i < 6; ++i) { \
            if (i < 4) kf[(i + 2) % 3] = A8_KFRAG(i + 2, kb_); else vf[i - 4] = A8_VFRAG(i - 4, vb_); \
            if (i == 0 && (t) + 2 < NT) A8_DMA_K0((t) + 2, ks_n2); \
            if (i == 1 && (t) + 2 < NT) A8_DMA_K1((t) + 2, ks_n2); \
            if (i == 2 && (t) + 1 < NT) A8_DMA_V((t) + 1, vs_next); \
            ATT_SBAR(); \
            if ((i & 1) == 0) PX0 = MFMA_F8(kf[i % 3], qr[i >> 1], i ? PX0 : negm, 0); else PX1 = MFMA_F8(kf[i % 3], qr[i >> 1], (i >> 1) ? PX1 : negm, 0); \
            _Pragma("unroll") for (int r = (16 * i) / 6; r < (16 * (i + 1)) / 6; ++r) { PY1[r] = __builtin_amdgcn_exp2f(PY1[r]); ps_ += PY0[r]; ps_ += PY1[r]; } \
            if (i >= 1 && i <= 4) { const int w_ = i - 1; int x_ = pk2_bf8(PY0[4 * w_], PY0[4 * w_ + 1], pp[w_], false); pp[w_] = pk2_bf8(PY0[4 * w_ + 2], PY0[4 * w_ + 3], x_, true); } \
            if (i == 3) { int x_ = pk2_bf8(PY1[0], PY1[1], pp[4], false); pp[4] = pk2_bf8(PY1[2], PY1[3], x_, true); } \
            if (i == 4) { int x_ = pk2_bf8(PY1[4], PY1[5], pp[5], false); pp[5] = pk2_bf8(PY1[6], PY1[7], x_, true); } \
            if (i == 5) { int x_ = pk2_bf8(PY1[8], PY1[9], pp[6], false); pp[6] = pk2_bf8(PY1[10], PY1[11], x_, true); int y_ = pk2_bf8(PY1[12], PY1[13], pp[7], false); pp[7] = pk2_bf8(PY1[14], PY1[15], y_, true); } \
            ATT_SBAR(); } \
        asm volatile("" : "+v"(pp));                                      \
        l_reg += ps_;                                                     \
        vf[2] = A8_VFRAG(2, vb_); \
        if ((t) >= NT - 4) mask_tile(PX0, PX1, 64 * (t), hi, 0, qidx); \
        A8_MIDBAR(t); \
        float ra_, rb_; \
        _Pragma("unroll") for (int d_ = 0; d_ < 4; ++d_) { \
            o[d_] = MFMA_F8(pp, vf[d_ % 3], o[d_], 1); \
            if (d_ == 0) { ATT_SBAR(); vf[0] = A8_VFRAG(3, vb_); } \
            if (d_ == 2 && (t) + 1 < NT) { ATT_SBAR(); kf[0] = A8_KFRAG(0, kp0 + ks_nxt); kf[1] = A8_KFRAG(1, kp0 + ks_nxt); } \
              \
            if (d_ == 0) { ra_ = fmaxf(fmaxf(PX0[0], PX0[1]), PX0[2]); rb_ = fmaxf(fmaxf(PX1[0], PX1[1]), PX1[2]); \
                _Pragma("unroll") for (int r = 3; r < 15; r += 2) { ra_ = fmaxf(fmaxf(ra_, PX0[r]), PX0[r + 1]); rb_ = fmaxf(fmaxf(rb_, PX1[r]), PX1[r + 1]); } \
                ra_ = fmaxf(fmaxf(ra_, PX0[15]), fmaxf(rb_, PX1[15])); } \
            _Pragma("unroll") for (int r = 4 * d_; r < 4 * d_ + 4; ++r) PX0[r] = __builtin_amdgcn_exp2f(PX0[r]); \
            ATT_SBAR(); } \
        { auto rr = __builtin_amdgcn_permlane32_swap(__float_as_uint(ra_), __float_as_uint(ra_), false, false); ra_ = fmaxf(__uint_as_float(rr[0]), __uint_as_float(rr[1])); } \
        if (__builtin_expect(__any(ra_ > BIAS8 + THR8), 0)) {        \
            const float dl_ = (ra_ > BIAS8 + THR8) ? ra_ - BIAS8 : 0.f, al_ = __builtin_amdgcn_exp2f(-dl_); \
            _Pragma("unroll") for (int r = 0; r < 16; ++r) { negm[r] -= dl_; PX0[r] *= al_; PX1[r] -= dl_; } \
            l_reg *= al_; if (hi == 0) wsf[r32] = al_; asm volatile("s_waitcnt lgkmcnt(0)" ::: "memory"); \
            _Pragma("unroll") for (int r = 0; r < 16; ++r) { const float f_ = wsf[crow(r, hi)]; _Pragma("unroll") for (int d2 = 0; d2 < 4; ++d2) o[d2][r] *= f_; } } \
        } while (0)
    for (int t = 1; t + 1 < NT; t += 2) {
        A8_STEP(pB0, pB1, pA0, pA1, t); A8_ROT();
        A8_STEP(pA0, pA1, pB0, pB1, t + 1); A8_ROT();
    }
    { float ps_ = 0.f;
#pragma unroll
      for (int r = 0; r < 16; ++r) { pA1[r] = __builtin_amdgcn_exp2f(pA1[r]); ps_ += pA0[r]; ps_ += pA1[r]; }
      l_reg += ps_;
      { auto rr = __builtin_amdgcn_permlane32_swap(__float_as_uint(l_reg), __float_as_uint(l_reg), false, false); l_reg = __uint_as_float(rr[0]) + __uint_as_float(rr[1]); }
#pragma unroll
      for (int w = 0; w < 4; ++w) { int x = pk2_bf8(pA0[4 * w], pA0[4 * w + 1], pp[w], false); pp[w] = pk2_bf8(pA0[4 * w + 2], pA0[4 * w + 3], x, true); int y = pk2_bf8(pA1[4 * w], pA1[4 * w + 1], pp[4 + w], false); pp[4 + w] = pk2_bf8(pA1[4 * w + 2], pA1[4 * w + 3], y, true); }
      const lds_cptr vb_ = vp0 + vs_prev;
#pragma unroll
      for (int d0 = 0; d0 < 4; ++d0) o[d0] = MFMA_F8(pp, A8_VFRAG(d0, vb_), o[d0], 1); }
    asm volatile("s_waitcnt lgkmcnt(0)\n\ts_barrier" ::: "memory");
    if (qb_next >= 0) { A8_DMA_K0(0, 0); A8_DMA_K1(0, 0); A8_DMA_V(0, 0); A8_DMA_K0(1, KT); A8_DMA_K1(1, KT);
      const unsigned char* Qw = Q8 + ((size_t)h * SEQ + qb_next * 256 + wid * 32 + r32) * DQK + 32 * hi;
#pragma unroll
      for (int s = 0; s < 3; ++s) qr[s] = ld32(Qw + 64 * s); }
    if (hi == 0) wsf[32 + r32] = l_reg;
    asm volatile("s_waitcnt lgkmcnt(0)" ::: "memory");
    { const int l2 = opq(lane), r2 = l2 & 31, h2 = l2 >> 5;
      LAS unsigned char* stg = (LAS unsigned char*)(shm + L_OST) + wid * 4096;
      unsigned char* Ow = (unsigned char*)Ob + (size_t)(qb * 256 + wid * 32) * D + h * DV;
#pragma unroll
      for (int r = 0; r < 16; ++r) { const int orow = crow(r, h2); const float li = __builtin_amdgcn_rcpf(wsf[32 + orow]) * O8SCALE;
#pragma unroll
          for (int d0 = 0; d0 < 4; ++d0) { const float v = o[d0][r] * li; stg[orow * 128 + d0 * 32 + r2] = (unsigned char)(__builtin_amdgcn_cvt_pk_fp8_f32(v, v, 0, false) & 0xff); } }
      asm volatile("s_waitcnt lgkmcnt(0)" ::: "memory");
#pragma unroll
      for (int i = 0; i < 4; ++i) { const int row = i * 8 + (l2 >> 3), ch = l2 & 7; const u32x4 v = *(const LAS u32x4*)(stg + row * 128 + ch * 16); *(u32x4*)(Ow + (size_t)row * D + ch * 16) = v; }
      asm volatile("s_waitcnt lgkmcnt(0)" ::: "memory"); }
#undef A8_KB
#undef A8_VB
#undef A8_DMA_K0
#undef A8_DMA_K1
#undef A8_DMA_V
#undef A8_ROT
#undef A8_KFRAG
#undef A8_VFRAG
#undef A8_MIDBAR
#undef A8_STEP
#undef pk2_bf8
}
#undef ATT_SBAR
#undef ATT_WAIT_BAR
}

__device__ __forceinline__ void attn8_phase(const Frame& F) {
    const int lane = (opq(F.tid) & 63);
    for (int it = blockIdx.x; it < 256; it += gridDim.x) {
        const int h = it & 7, x = it >> 3;
        v8i qr[3];
#pragma unroll 1
        for (int pass = 0; pass < 2; ++pass) att8::attn_unit(h, pass ? x : 63 - x, F_Q8, F_K8, F_VT8, F_OB, (char*)F.lds, lane, F.wave, qr, pass == 1, pass == 0 ? x : -1);
    }
}

template <class Epi>
__device__ __forceinline__ void meta_gemm(const Frame& F, const bf16* A, int lda, const bf16* Bt, int N, int K, const Epi& E, int first_wg = 0) {
    const int lane = (opq(F.tid) & 63), fr = lane & 15, fq = lane >> 4, nun = (N / 256) * 4, kw = K / NWAVES;
    LAS f32x4* red = (LAS f32x4*)F.lds;
    for (int u = (int)blockIdx.x - first_wg; u >= 0 && u < nun; u += (int)gridDim.x - first_wg) {
        const int g = u & 3, pn = u >> 2;
        const bf16* arow[1] = {A + (size_t)fr * lda + F.wave * kw};
        f32x4 acc[1][2][2];
        wave_mma<1>(arow, Bt + (size_t)(pn * 256 + g * 32) * K + F.wave * kw, kw, lane, acc, K);
        __syncthreads();
#pragma unroll
        for (int j = 0; j < 4; ++j) red[(F.wave * 4 + j) * 64 + lane] = acc[0][j >> 1][j & 1];
        __syncthreads();
        if (F.wave == 0) { f32x4 s[4];
#pragma unroll
            for (int j = 0; j < 4; ++j) { s[j] = red[j * 64 + lane];
#pragma unroll
                for (int w = 1; w < NWAVES; ++w) s[j] = s[j] + red[(w * 4 + j) * 64 + lane]; }
            E.row(fr, pn, g, fq, s[0], s[1], s[2], s[3], true); }
    }
    __syncthreads();
}
__device__ __forceinline__ void meta_kvq(const Frame& F) {
    if ((int)blockIdx.x != (int)gridDim.x - 1) return;
    const int lane = (opq(F.tid) & 63), fr = lane & 15, fq = lane >> 4, kw = D / NWAVES;
    LAS f32x4* red = (LAS f32x4*)F.lds; LAS float* rs = (LAS float*)(F.lds + 32768);
    const bf16* arow[1] = {F_H2 + (size_t)fr * D + F.wave * kw};
    const float s = F_STAT[ST_RSTD2 + fr];
    f32x4 part[5][1][2][2];
#pragma unroll
    for (int u = 0; u < 5; ++u) wave_mma<1>(arow, F_WKVQ + (size_t)(u < 4 ? u * 32 : 512 + 96) * D + F.wave * kw, kw, lane, part[u], D);
    f32x4 mine[4];
#pragma unroll
    for (int u = 0; u < 5; ++u) {
        __syncthreads();
#pragma unroll
        for (int j = 0; j < 4; ++j) red[(F.wave * 4 + j) * 64 + lane] = part[u][0][j >> 1][j & 1];
        __syncthreads();
        if (F.wave == u) {
#pragma unroll
            for (int j = 0; j < 4; ++j) { f32x4 t = red[j * 64 + lane];
#pragma unroll
                for (int w = 1; w < NWAVES; ++w) t = t + red[(w * 4 + j) * 64 + lane];
                mine[j] = t * s; } }
    }
    if (F.wave < 4) { float ss = sumsq8(mine[0], mine[1]) + sumsq8(mine[2], mine[3]); ss += __shfl_xor(ss, 16); ss += __shfl_xor(ss, 32); if (fq == 0) rs[F.wave * 16 + fr] = ss; }
    __syncthreads();
    if (F.wave < 4) { const float tot = (rs[fr] + rs[16 + fr]) + (rs[32 + fr] + rs[48 + fr]); const float rn = 1.f / sqrtf(tot * (1.f / KVRANK) + EPS); const int c = 32 * F.wave + 8 * fq;
        st8(F_CKV + (size_t)fr * KVRANK + c, mine[0] * rn, mine[1] * rn); st8(F_CKV + (size_t)fr * KVRANK + 128 + c, mine[2] * rn, mine[3] * rn); }
    else if (F.wave == 4) { f32x4 o1a, o1b, o2a, o2b; rope8(F_ROPE + ((size_t)fr * 32 + 8 * fq) * 2, mine[0], mine[1], mine[2], mine[3], o1a, o1b, o2a, o2b); krope_store8(F_K8, fr, 8 * fq, o1a, o1b, o2a, o2b); }
    __syncthreads();
}

template <bool ALIGN, class Fn, bool F8 = false>
__device__ __forceinline__ void dense_gemm(const Frame& F, const void* A_main, int N, int K, const void* Bt, const Fn& fn, int M = SEQ, int prow0 = NMETA, int nwg = 0) {
    if (nwg > 0 && (int)blockIdx.x >= nwg) return;
    const pg8::Gemm g{(const bf16*)A_main, (const bf16*)Bt, M, N, F8 ? K / 2 : K}; pg8::StaticOrder S; S.init(M, N, nwg > 0 ? nwg : (int)gridDim.x, (int)blockIdx.x);
    const EpiRows<Fn> E{fn, prow0};
    pg8::gemm_phase<EpiRows<Fn>, pg8::StaticOrder, ALIGN, true, F8>(F.lds, g, S, E);
}

__global__ void __launch_bounds__(NTHREADS, 2) yoco_fwd(Params P) {
    extern __shared__ __attribute__((aligned(16))) unsigned char lds_raw[];
    Frame F;
    F.lds = (LAS unsigned char*)lds_raw;
    F.tid = threadIdx.x; F.wave = __builtin_amdgcn_readfirstlane(F.tid >> 6);
    F.gw = blockIdx.x * NWAVES + F.wave; F.ngw = gridDim.x * NWAVES;
    F.ws = P.ws; F.P = &P;

    for (int u = F.tid; u < (LDS_BYTES - MISC_OFF) / 4; u += NTHREADS) ((LAS unsigned*)(F.lds + MISC_OFF))[u] = 0u;
    __syncthreads();
    XcdBarrier bar = xcd_barrier_post(F_CTL + CW_BAR, (volatile LAS unsigned*)(F.lds + MISC_OFF) + 8);
#define GRID_BAR() xcd_barrier(bar)

#ifdef ONLY_PH
#define PH(k) ((k) == ONLY_PH)
#else
#define PH(k) true
#endif
#ifdef REPEAT_MASK
#define NREP(k) ((((REPEAT_MASK) >> (k)) & 1) ? 2 : 1)
#else
#define NREP(k) 1
#endif
#ifdef REPEAT_MASK
#define PH_BEGIN(k) _Pragma("unroll") for (int rep_ = 0; rep_ < NREP(k); ++rep_) {
#else
#define PH_BEGIN(k) {
#endif
#define PH_END() GRID_BAR(); }
    PH_BEGIN(0)
    if (PH(0)) p0_prologue(F);
    PH_END()
    PH_BEGIN(1)
    if (PH(1)) { const EpiIn E{F_BB, F_ZB, F_STAT + ST_RSTD0}; if (gridDim.x >= 256) { dense_gemm<true>(F, F_H0B + (size_t)NMETA * D, 3072, 1024, F_WIN, E, SEQ, NMETA, 192);
            if ((int)blockIdx.x >= 192) { const int lane = (opq(F.tid) & 63), nfree = (int)gridDim.x - 192, rank = (int)blockIdx.x - 192;
                for (int it = rank * NWAVES + F.wave; it < L0_P1 * IT_EXP; it += nfree * NWAVES) expert_item(F, L0_PRO * IT_EXP + it, nullptr, lane); } }
        else dense_gemm<true>(F, F_H0B + (size_t)NMETA * D, 3072, 1024, F_WIN, E);
        meta_gemm(F, F_H0B, D, F_WIN, 3072, 1024, E); }
    PH_END()
    PH_BEGIN(2)
    if (PH(2)) conv_phase(F);
    PH_END()
    PH_BEGIN(3)
    if (PH(3)) { const EpiOut E{F_H13, F_H0B, F_H8}; dense_gemm<true>(F, F_A2 + (size_t)NMETA * D, 1024, 1024, F_WOUT, E); meta_gemm(F, F_A2, D, F_WOUT, 1024, 1024, E); }
    PH_END()
#if defined(PROBE_ROUTER) && PROBE_ROUTER == 4
    router_phase(F, F_H13, F_WR, F_STAT + ST_RSTD1, F_CTL + CW_CNT + 128, 0, (L0_PRO + L0_P1) * IT_EXP, (NE - L0_PRO - L0_P1) * IT_EXP); GRID_BAR();
#endif
    if (PH(4)) router_phase(F, F_H13, F_WR, F_STAT + ST_RSTD1, F_CTL + CW_CNT, 0, (L0_PRO + L0_P1) * IT_EXP, (NE - L0_PRO - L0_P1) * IT_EXP);
    GRID_BAR();
    moe_tables(F, F_CTL + CW_CNT);
    PH_BEGIN(5)
    if (PH(5)) moe_gu_fast(F, F_H13, F_STAT + ST_RSTD1, 0);
    PH_END()
    PH_BEGIN(6)
    if (PH(6)) moe_down_fast(F, 0);
    PH_END()
    PH_BEGIN(7)
    if (PH(7)) combine_phase<false>(F, F_H13, F_H2, F_STAT + ST_RSTD2, 0);
    PH_END()
    PH_BEGIN(8)
    if (PH(8)) { const int gt = F.gw * 64 + (opq(F.tid) & 63), ngt = F.ngw * 64;
      for (int idx = gt; idx < NH * KPAD * (DQK / 16); idx += ngt) { const int h = idx / (KPAD * (DQK / 16)), rem = idx % (KPAD * (DQK / 16)); *(u32x4*)(F_K8 + k8_off(h, rem / (DQK / 16), 16 * (rem % (DQK / 16)))) = (u32x4){0u, 0u, 0u, 0u}; }
      for (int idx = gt; idx < NH * 128 * 4; idx += ngt) { const int h = idx / 512, rem = idx % 512; *(u32x4*)(F_VT8 + (size_t)h * NKT * 128 * 64 + rem * 16) = (u32x4){0u, 0u, 0u, 0u}; }
      const EpiKvqFused E{F_CKV, F_CQ, F_K8, F_STAT + ST_RSTD2, F_STAT + ST_SSCQ, F_ROPE};
      const pg8::Gemm g{F_H2 + (size_t)NMETA * D, F_WKVQ, SEQ, 768, 1024}; pg8::StaticOrder S; S.init(SEQ, 768, (int)gridDim.x, (int)blockIdx.x);
      pg8::gemm_phase<EpiKvqFused, pg8::StaticOrder, false, true>(F.lds, g, S, E);
      meta_kvq(F);
      { const int G = (int)gridDim.x, first = 192; int nfree = G - 1 - first, rank = (int)blockIdx.x - first;
        if (nfree <= 0) { nfree = G; rank = (int)blockIdx.x; }
        if (rank >= 0 && rank < nfree) { const int lane = (opq(F.tid) & 63);
            for (int it = rank * NWAVES + F.wave; it < L1_P8 * IT_EXP; it += nfree * NWAVES) expert_item(F, (NE + L1_P5) * IT_EXP + it, nullptr, lane); } } }
    PH_END()
    PH_BEGIN(9)
    if (PH(9)) { const EpiKnope8 E{F_K8}; dense_gemm<false>(F, F_CKV + (size_t)NMETA * KVRANK, 1024, 256, F_WK, E); meta_gemm(F, F_CKV, KVRANK, F_WK, 1024, 256, E, gridDim.x >= 256 ? 128 : 0); }
    if (PH(91)) { const EpiVt8 E{F_VT8}; dense_gemm<false>(F, F_WV, SEQ, 256, F_CKV + (size_t)NMETA * KVRANK, E, 1024, 0); const EpiVt8Meta Em{F_VT8}; meta_gemm(F, F_CKV, KVRANK, F_WV, 1024, 256, Em, gridDim.x >= 256 ? 128 : 0); }
    if (PH(90)) { const EpiQUp8 E{F_Q8, F_STAT + ST_SSCQ, F_ROPE}; dense_gemm<true>(F, F_CQ + (size_t)NMETA * QRANK, 1536, 384, F_WUQ, E); }
    PH_END()
    PH_BEGIN(10)
    if (PH(10)) attn8_phase(F);
    PH_END()
    PH_BEGIN(11)
    if (PH(11)) { const EpiRes E{F_H13, F_H2, F_H8, 1.f / (WO8SCALE * O8SCALE), 0}; dense_gemm<true, EpiRes, true>(F, F_O8, 1024, 1024, F_WO, E);
        { const int lane = (opq(F.tid) & 63), e0 = L1_P5 + L1_P8 + L1_P12;
          for (int it = F.gw; it < (NE - e0) * IT_EXP; it += F.ngw) expert_item(F, (NE + e0) * IT_EXP + it, nullptr, lane); } }
    PH_END()
#if defined(PROBE_ROUTER) && PROBE_ROUTER == 12
    router_phase(F, F_H13, F_WR + 96 * 1024, F_STAT + ST_RSTD3, F_CTL + CW_CNT + 192, NMETA, (NE + L1_P5 + L1_P8) * IT_EXP, L1_P12 * IT_EXP); GRID_BAR();
#endif
    if (PH(12)) router_phase(F, F_H13, F_WR + 96 * 1024, F_STAT + ST_RSTD3, F_CTL + CW_CNT + 64, NMETA, (NE + L1_P5 + L1_P8) * IT_EXP, L1_P12 * IT_EXP);
    GRID_BAR();
    moe_tables(F, F_CTL + CW_CNT + 64);
    PH_BEGIN(13)
    if (PH(13)) moe_gu_fast(F, F_H13, F_STAT + ST_RSTD3, 1);
    PH_END()
    PH_BEGIN(14)
    if (PH(14)) moe_down_fast(F, 1);
    PH_END()
    PH_BEGIN(15) if (PH(15)) combine_phase<true>(F, F_H13, nullptr, nullptr, NMETA); }
}

extern "C" void kernel_launch(void* const* d_in, const int* in_sizes, int n_in, void* d_out, int out_size, void* d_ws, size_t ws_size, hipStream_t stream) {
    static int grid = 0;
    if (grid == 0) {
        if (n_in != 21 || out_size != SEQ * D || ws_size < WS_END) { fprintf(stderr, "kernel_launch: unexpected shapes (n_in %d out %d ws %zu, need %zu)\n", n_in, out_size, ws_size, (size_t)WS_END); grid = -1; return; }
        int dev = 0, cus = 0, per_cu = 0;
        if (hipGetDevice(&dev) != hipSuccess || hipDeviceGetAttribute(&cus, hipDeviceAttributeMultiprocessorCount, dev) != hipSuccess) { grid = -1; return; }
        if (hipFuncSetAttribute((const void*)yoco_fwd, hipFuncAttributeMaxDynamicSharedMemorySize, LDS_BYTES) != hipSuccess) { fprintf(stderr, "kernel_launch: hipFuncSetAttribute failed\n"); grid = -1; return; }
        if (hipOccupancyMaxActiveBlocksPerMultiprocessor(&per_cu, (const void*)yoco_fwd, NTHREADS, LDS_BYTES) != hipSuccess || per_cu < 1) { fprintf(stderr, "kernel_launch: occupancy query says %d\n", per_cu); (void)hipGetLastError(); grid = -1; return; }
        grid = cus;
    }
    if (grid < 0) return;
    if (hipMemsetAsync((char*)d_ws + WS_CTL, 0, CTL_ZERO_BYTES, stream) != hipSuccess) return;
    Params p{};
    for (int i = 0; i < 21; ++i) p.in[i] = (const float*)d_in[i];
    p.out = (float*)d_out; p.ws = (unsigned char*)d_ws; p.pad0 = 0; p.pad1 = 0;
    hipLaunchKernelGGL(yoco_fwd, dim3(grid), dim3(NTHREADS), LDS_BYTES, stream, p);
}
```
